# Optimizing an MI355X kernel written in HIP

```python
import jax, jax.numpy as jnp
from jax import lax
import numpy as np

D_MODEL = 2048
BATCH = 2
SEQ = 4096
DEPTH = 1
DEC_BATCH = 8
DEC_SEQ = 64
PAST_LEN = 1024

CHUNK = 64
D_PLE = 256
D_FF = 5504
D_CONV = D_MODEL // 2
CONV_WIDTH = 31
HEAD_DIM = 64
N_HEADS = (D_MODEL // 2) // HEAD_DIM
N_KV = 4
GROUP = N_HEADS // N_KV
ROT_DIM = HEAD_DIM // 4
ROPE_THETA = 500000.0
WINDOW = 128
W_CHUNKS = WINDOW // CHUNK
EPS = 1e-6
Q_W = N_HEADS * HEAD_DIM
KV_W = N_KV * HEAD_DIM
IN_SPLITS = (D_CONV, 2 * D_CONV, 2 * D_CONV + Q_W, 2 * D_CONV + Q_W + KV_W,
             2 * D_CONV + Q_W + 2 * KV_W, 2 * D_CONV + Q_W + 2 * KV_W + D_MODEL)
IN_COLS = 2 * D_CONV + Q_W + 2 * KV_W + 2 * D_MODEL
NEG = -1e30

kernel_name = "hybrid_conformer_swa_sink_stream_step"


def rms_norm(x, g):
    xf = x.astype(jnp.float32)
    y = xf * lax.rsqrt(jnp.mean(xf * xf, -1, keepdims=True) + EPS)
    return (y * g.astype(jnp.float32)).astype(x.dtype)


def layer_norm(x, g, b):
    xf = x.astype(jnp.float32)
    mu = jnp.mean(xf, -1, keepdims=True)
    xc = xf - mu
    y = xc * lax.rsqrt(jnp.mean(xc * xc, -1, keepdims=True) + EPS)
    return (y * g.astype(jnp.float32) + b.astype(jnp.float32)).astype(x.dtype)


def swiglu(x, w_gu, w_down):
    g, u = jnp.split(x @ w_gu, 2, axis=-1)
    return (jax.nn.silu(g) * u) @ w_down


def rotary(x, pos):
    half = ROT_DIM // 2
    inv = ROPE_THETA ** (-jnp.arange(0, ROT_DIM, 2, dtype=jnp.float32) / ROT_DIM)
    ang = pos.astype(jnp.float32)[:, None] * inv[None, :]
    cos = jnp.cos(ang)[:, None, :]
    sin = jnp.sin(ang)[:, None, :]
    xr = x[..., :ROT_DIM].astype(jnp.float32)
    x1, x2 = xr[..., :half], xr[..., half:]
    rot = jnp.concatenate([x1 * cos - x2 * sin, x2 * cos + x1 * sin], -1)
    return jnp.concatenate([rot.astype(x.dtype), x[..., ROT_DIM:]], -1)


def depthwise_causal_conv(u_ext, w, b):
    y = lax.conv_general_dilated(u_ext, w[:, None, :], (1,), 'VALID',
                                 dimension_numbers=('NWC', 'WIO', 'NWC'),
                                 feature_group_count=u_ext.shape[-1])
    return y + b


def sink_attention(q, k, v, sinks, mask):
    s = jnp.einsum('...qhgd,...khd->...hgqk', q, k).astype(jnp.float32) * (HEAD_DIM ** -0.5)
    if mask is not None:
        s = jnp.where(mask, s, NEG)
    sink = jnp.broadcast_to(sinks.astype(jnp.float32)[..., None, None], s.shape[:-1] + (1,))
    p = jax.nn.softmax(jnp.concatenate([s, sink], -1), axis=-1)[..., :-1]
    return jnp.einsum('...hgqk,...khd->...qhgd', p.astype(v.dtype), v)


def window_attention_prompt(q, k, v, sinks):
    n, t = q.shape[:2]
    nc = t // CHUNK
    qb = q.reshape(n, nc, CHUNK, N_KV, GROUP, HEAD_DIM)
    pad = ((0, 0), (W_CHUNKS * CHUNK, 0), (0, 0), (0, 0))
    kp = jnp.pad(k, pad).reshape(n, nc + W_CHUNKS, CHUNK, N_KV, HEAD_DIM)
    vp = jnp.pad(v, pad).reshape(n, nc + W_CHUNKS, CHUNK, N_KV, HEAD_DIM)
    kb = jnp.concatenate([kp[:, j:j + nc] for j in range(W_CHUNKS + 1)], axis=2)
    vb = jnp.concatenate([vp[:, j:j + nc] for j in range(W_CHUNKS + 1)], axis=2)
    key_chunk = (jnp.arange(nc)[:, None]
                 + (jnp.arange((W_CHUNKS + 1) * CHUNK) // CHUNK)[None, :] - W_CHUNKS)
    mask = (key_chunk >= 0)[:, None, None, None, :]
    o = sink_attention(qb, kb, vb, sinks, mask)
    return o.reshape(n, t, Q_W)


def layer(x, pe, pos, conv_past, k_past, v_past,
          ffn1_norm, ffn1_w_gu, ffn1_w_down, mix_norm, w_in, conv_w, conv_b, conv_ln_g, conv_ln_b,
          conv_w_out, attn_sinks, attn_w_out, w_out, ffn2_norm, ffn2_w_gu, ffn2_w_down,
          ple_norm, ple_w_gate, ple_w_proj):
    n, t = x.shape[:2]
    x = x + 0.5 * swiglu(rms_norm(x, ffn1_norm), ffn1_w_gu, ffn1_w_down)
    h = rms_norm(x, mix_norm)
    a_lin, a_gate, q, k, v, g_conv, g_attn = jnp.split(h @ w_in, IN_SPLITS, axis=-1)
    u = a_lin * jax.nn.sigmoid(a_gate)
    u_ext = jnp.concatenate([conv_past, u], axis=1)
    y_conv = jax.nn.silu(layer_norm(depthwise_causal_conv(u_ext, conv_w, conv_b),
                                    conv_ln_g, conv_ln_b)) @ conv_w_out
    new_conv = u_ext[:, -(CONV_WIDTH - 1):]
    q = rotary(q.reshape(n, t, N_HEADS, HEAD_DIM), pos)
    k = rotary(k.reshape(n, t, N_KV, HEAD_DIM), pos)
    v = v.reshape(n, t, N_KV, HEAD_DIM)
    sinks = attn_sinks.reshape(N_KV, GROUP)
    if k_past is None:
        o = window_attention_prompt(q, k, v, sinks)
        new_k, new_v = k[:, -WINDOW:], v[:, -WINDOW:]
    else:
        kc = jnp.concatenate([k_past, k], axis=1)
        vc = jnp.concatenate([v_past, v], axis=1)
        o = sink_attention(q.reshape(n, t, N_KV, GROUP, HEAD_DIM), kc, vc, sinks, None)
        o = o.reshape(n, t, Q_W)
        w_rows = k_past.shape[1]
        new_k, new_v = kc[:, -w_rows:], vc[:, -w_rows:]
    y_attn = o @ attn_w_out
    x = x + (jax.nn.sigmoid(g_conv) * y_conv + jax.nn.sigmoid(g_attn) * y_attn) @ w_out
    x = x + 0.5 * swiglu(rms_norm(x, ffn2_norm), ffn2_w_gu, ffn2_w_down)
    x = x + jax.nn.sigmoid(rms_norm(x, ple_norm) @ ple_w_gate) * (pe @ ple_w_proj)
    return x, new_conv, new_k, new_v


def setup_inputs(seed: int = 0) -> dict:
    key = jax.random.key(seed)
    ks = iter(jax.random.split(key, 40))
    f32 = jnp.float32
    w_rows = min(WINDOW, PAST_LEN)

    def nrm(shape, scale=1.0):
        return jax.random.normal(next(ks), shape, f32) * scale

    def gain(shape):
        return 1.0 + nrm(shape, 0.02)

    return {
        "x_prompt": nrm((BATCH, SEQ, D_MODEL)),
        "x_sample": nrm((DEC_BATCH, DEC_SEQ, D_MODEL)),
        "p_prompt": nrm((DEPTH, BATCH, SEQ, D_PLE)),
        "p_sample": nrm((DEPTH, DEC_BATCH, DEC_SEQ, D_PLE)),
        "state_conv": nrm((DEPTH, DEC_BATCH, CONV_WIDTH - 1, D_CONV)),
        "cache_k": nrm((DEPTH, DEC_BATCH, w_rows, N_KV, HEAD_DIM)),
        "cache_v": nrm((DEPTH, DEC_BATCH, w_rows, N_KV, HEAD_DIM)),
        "ffn1_norm": gain((DEPTH, D_MODEL)),
        "ffn1_w_gu": nrm((DEPTH, D_MODEL, 2 * D_FF), D_MODEL ** -0.5),
        "ffn1_w_down": nrm((DEPTH, D_FF, D_MODEL), D_FF ** -0.5),
        "mix_norm": gain((DEPTH, D_MODEL)),
        "w_in": nrm((DEPTH, D_MODEL, IN_COLS), D_MODEL ** -0.5),
        "conv_w": nrm((DEPTH, CONV_WIDTH, D_CONV), CONV_WIDTH ** -0.5),
        "conv_b": nrm((DEPTH, D_CONV), 0.02),
        "conv_ln_g": gain((DEPTH, D_CONV)),
        "conv_ln_b": nrm((DEPTH, D_CONV), 0.02),
        "conv_w_out": nrm((DEPTH, D_CONV, D_MODEL), D_CONV ** -0.5),
        "attn_sinks": nrm((DEPTH, N_HEADS), 0.5),
        "attn_w_out": nrm((DEPTH, Q_W, D_MODEL), Q_W ** -0.5),
        "w_out": nrm((DEPTH, D_MODEL, D_MODEL), D_MODEL ** -0.5),
        "ffn2_norm": gain((DEPTH, D_MODEL)),
        "ffn2_w_gu": nrm((DEPTH, D_MODEL, 2 * D_FF), D_MODEL ** -0.5),
        "ffn2_w_down": nrm((DEPTH, D_FF, D_MODEL), D_FF ** -0.5),
        "ple_norm": gain((DEPTH, D_MODEL)),
        "ple_w_gate": nrm((DEPTH, D_MODEL, D_MODEL), D_MODEL ** -0.5),
        "ple_w_proj": nrm((DEPTH, D_PLE, D_MODEL), D_PLE ** -0.5),
        "final_norm": gain((D_MODEL,)),
    }


def reference(x_prompt, x_sample, p_prompt, p_sample, state_conv, cache_k, cache_v,
              ffn1_norm, ffn1_w_gu, ffn1_w_down, mix_norm, w_in, conv_w, conv_b, conv_ln_g, conv_ln_b,
              conv_w_out, attn_sinks, attn_w_out, w_out, ffn2_norm, ffn2_w_gu, ffn2_w_down,
              ple_norm, ple_w_gate, ple_w_proj, final_norm):
    pos_p = jnp.arange(x_prompt.shape[1], dtype=jnp.int32)
    pos_s = PAST_LEN + jnp.arange(x_sample.shape[1], dtype=jnp.int32)
    zero_conv = jnp.zeros((x_prompt.shape[0], CONV_WIDTH - 1, D_CONV), x_prompt.dtype)
    hp, hs = x_prompt, x_sample
    kp_l, vp_l, cp_l, ks_l, vs_l, cs_l = [], [], [], [], [], []
    for i in range(DEPTH):
        w = (ffn1_norm[i], ffn1_w_gu[i], ffn1_w_down[i], mix_norm[i], w_in[i], conv_w[i], conv_b[i],
             conv_ln_g[i], conv_ln_b[i], conv_w_out[i], attn_sinks[i], attn_w_out[i], w_out[i],
             ffn2_norm[i], ffn2_w_gu[i], ffn2_w_down[i], ple_norm[i], ple_w_gate[i], ple_w_proj[i])
        hp, c_p, k_p, v_p = layer(hp, p_prompt[i], pos_p, zero_conv, None, None, *w)
        hs, c_s, k_s, v_s = layer(hs, p_sample[i], pos_s, state_conv[i], cache_k[i], cache_v[i], *w)
        kp_l.append(k_p); vp_l.append(v_p); cp_l.append(c_p)
        ks_l.append(k_s); vs_l.append(v_s); cs_l.append(c_s)
    y_prompt = rms_norm(hp, final_norm)
    y_sample = rms_norm(hs, final_norm)
    return (y_prompt, y_sample, jnp.stack(kp_l), jnp.stack(vp_l), jnp.stack(cp_l),
            jnp.stack(ks_l), jnp.stack(vs_l), jnp.stack(cs_l))
```

```cpp
#include <hip/hip_runtime.h>
#include <hip/hip_cooperative_groups.h>
#include <cstdio>
#include <cstdint>
namespace cg = cooperative_groups;

#ifndef MK_N_LAUNCHES
#define MK_N_LAUNCHES 1
#endif

#define GAS __attribute__((address_space(1)))
#define LAS __attribute__((address_space(3)))
typedef unsigned short bf16_t;
typedef short bf16x8 __attribute__((ext_vector_type(8)));
typedef float f32x4 __attribute__((ext_vector_type(4)));
typedef float f32x2 __attribute__((ext_vector_type(2)));
typedef float f32x16 __attribute__((ext_vector_type(16)));
typedef unsigned u32x4 __attribute__((ext_vector_type(4)));
typedef unsigned u32x2 __attribute__((ext_vector_type(2)));

constexpr int DM = 2048, DFF = 5504, DCONV = 1024, QW = 1024, KVW = 256, INC = 7680, DPLE = 256;
constexpr int SEQ = 4096, DSEQ = 64, NBP = 2, NBS = 8, CW = 31, WIN = 128;
constexpr int MP = NBP * SEQ, MS = NBS * DSEQ, M = MP + MS;
constexpr int PAST = 1024;
constexpr float EPS = 1e-6f;
constexpr size_t OFF_Y = 0;
constexpr size_t OFF_KP = (size_t)M * DM;
constexpr size_t OFF_VP = OFF_KP + (size_t)NBP * WIN * KVW;
constexpr size_t OFF_CP = OFF_VP + (size_t)NBP * WIN * KVW;
constexpr size_t OFF_KS = OFF_CP + (size_t)NBP * 30 * DCONV;
constexpr size_t OFF_VS = OFF_KS + (size_t)NBS * WIN * KVW;
constexpr size_t OFF_CS = OFF_VS + (size_t)NBS * WIN * KVW;
constexpr size_t OUT_TOTAL = OFF_CS + (size_t)NBS * 30 * DCONV;

constexpr size_t MiB = 1u << 20;
constexpr size_t al(size_t x) { return (x + 4095) & ~(size_t)4095; }
constexpr size_t WS_CTL = 0, CTL_ZERO_BYTES = 64 * 1024;
constexpr size_t WS_WGU1 = 1 * MiB;
constexpr size_t WS_WD1 = WS_WGU1 + al((size_t)2 * DFF * DM * 2);
constexpr size_t WS_WIN = WS_WD1 + al((size_t)DM * DFF * 2);
constexpr size_t WS_WCO = WS_WIN + al((size_t)INC * DM * 2);
constexpr size_t WS_WAO = WS_WCO + al((size_t)DM * DCONV * 2);
constexpr size_t WS_WOUT = WS_WAO + al((size_t)DM * QW * 2);
constexpr size_t WS_WGU2 = WS_WOUT + al((size_t)DM * DM * 2);
constexpr size_t WS_WD2 = WS_WGU2 + al((size_t)2 * DFF * DM * 2);
constexpr size_t WS_WPG = WS_WD2 + al((size_t)DM * DFF * 2);
constexpr size_t WS_WPE = WS_WPG + al((size_t)DM * DM * 2);
constexpr size_t WS_XB = WS_WPE + al((size_t)DM * DPLE * 2);
constexpr size_t WS_PB = WS_XB + al((size_t)M * DM * 2);
constexpr size_t WS_ROPE = WS_PB + al((size_t)M * DPLE * 2);
constexpr size_t WS_SS = WS_ROPE + al((size_t)2 * 4160 * 8 * 4);
constexpr size_t SS_BYTES = al((size_t)M * 32 * 4);
constexpr size_t WS_R = WS_SS + 5 * SS_BYTES;
constexpr int UROWS = M + 30 * (NBP + NBS);
constexpr size_t R_U = 0, R_Q = R_U + (size_t)UROWS * DCONV * 2, R_K = R_Q + (size_t)M * QW * 2, R_V = R_K + (size_t)M * KVW * 2,
                 R_GA = R_V + (size_t)M * KVW * 2, R_GB = R_GA + (size_t)M * DM * 2, R_END = R_GB + (size_t)M * DM * 2;
static_assert(R_END >= (size_t)M * DFF * 2 && R_END >= (size_t)M * DM * 4, "region R");
constexpr size_t WS_SLAB = WS_R + al(R_END);
constexpr size_t WS_PROJ = WS_SLAB + (size_t)256 * 65536 * 2;
constexpr size_t WS_END = WS_PROJ + al((size_t)M * DM * 2);
constexpr int CW_FLAG = 8192;
constexpr int CW_BAR = 1024;

constexpr int RING_BYTES = 131072, LDSCTL_OFF = RING_BYTES, MISC_OFF = LDSCTL_OFF + 320, LDS_BYTES = 147456;
constexpr int NWAVES = 8;

typedef __bf16 bf16x2_t __attribute__((ext_vector_type(2)));
__device__ __forceinline__ unsigned cvt_pk_bf16(float lo, float hi) { f32x2 v = {lo, hi}; bf16x2_t b = __builtin_convertvector(v, bf16x2_t); return __builtin_bit_cast(unsigned, b); }
__device__ __forceinline__ float bf2f(unsigned h) { return __uint_as_float(h << 16); }
__device__ __forceinline__ int urow(int r) { return r < MP ? r + 30 * ((r >> 12) + 1) : r + 30 * (((r - MP) >> 6) + 3); }
__device__ __forceinline__ float fsigmoid(float x) { return __builtin_amdgcn_rcpf(1.f + __expf(-x)); }

namespace pg8 {
constexpr int BM = 256, BK = 64, HALF = 128, HTB = HALF * BK * 2, STAGE_BYTES = 8 * HTB, NXCD = 8, WGM = 8;
__host__ __device__ __forceinline__ int lds_byte(int r, int c) { const int st = (r >> 4) * 2 + (c >> 5), rr = r & 15, cc = c & 31, ob = rr * 64 + cc * 2; return st * 1024 + (ob ^ (((ob >> 9) & 1) << 5)); }
__host__ __device__ __forceinline__ void stage_rc(int b, int& R, int& C) { const int st = b / 1024, sb = b % 1024, swz = sb ^ (((sb >> 9) & 1) << 5); R = (st >> 1) * 16 + swz / 64; C = (st & 1) * 32 + (swz % 64) / 2; }
__host__ __device__ __forceinline__ int perm32(int rho) { const int n = rho >> 4, i = rho & 15; return 8 * (i >> 2) + 4 * n + (i & 3); }

struct Unit { int pm, pn, kt0, ntu, kind, slab, ui; };
struct Gemm { const bf16_t* A; const bf16_t* Bt; int M, N, K; };

struct StaticOrder {
    int nM, nN, nwg, G, c, ntK;
    __host__ __device__ void init(int M_, int N_, int K_, int G_, int c_) { nM = M_ / BM; nN = N_ / BM; nwg = nM * nN; G = G_; c = c_; ntK = K_ / BK; }
    __host__ __device__ __forceinline__ bool next(int i, Unit& u) const {
        const long L = (long)i * G + c; if (L >= nwg) return false;
        int wgid = (int)L; { const int q = nwg / NXCD, r = nwg % NXCD, xcd = wgid % NXCD, off = wgid / NXCD; wgid = (xcd < r ? xcd * (q + 1) : r * (q + 1) + (xcd - r) * q) + off; }
        const int nig = WGM * nN, gid = wgid / nig, fm = gid * WGM, gsz = (nM - fm) < WGM ? (nM - fm) : WGM;
        u.pm = fm + ((wgid % nig) % gsz); u.pn = (wgid % nig) / gsz; u.kt0 = 0; u.ntu = ntK; u.kind = 0; u.slab = 0; u.ui = i; return true;
    }
    __device__ __forceinline__ void a_ready(const Unit&) const {}
    __device__ __forceinline__ void done(const Unit&) const {}
};

struct StreamK {
    int P, v; long s, e;
    __device__ __forceinline__ void init(int K_, int G_, int bx) {
        P = K_ / 128; v = bx; if (G_ == 256) { const int x = bx & 7, j = bx >> 3; v = 16 * (j >> 1) + 2 * x + (j & 1); }
        const long tot = 272L * P; s = (long)v * tot / G_; e = (long)(v + 1) * tot / G_; }
    __device__ __forceinline__ bool next(int i, Unit& u) const {
        const long t = s / P + i, lo = s > t * P ? s : t * P, hi = e < (t + 1) * P ? e : (t + 1) * P;
        if (lo >= hi) return false;
        const int a = (int)(t / 17), b = (int)(t % 17);
        if (b < 16) { u.pm = 4 * (b >> 1) + (a >> 2); u.pn = 4 * (b & 1) + (a & 3); } else { u.pm = 32 + (a >> 3); u.pn = a & 7; }
        u.kt0 = 2 * (int)(lo - t * P); u.ntu = 2 * (int)(hi - lo);
        u.kind = (hi - lo == P) ? 0 : (lo == t * P ? 2 : 1); u.slab = (u.kind == 1) ? v : v + 1; u.ui = i;
        return true;
    }
    __device__ __forceinline__ void a_ready(const Unit&) const {}
    __device__ __forceinline__ void done(const Unit&) const {}
};

struct SlackOrder {
    int first, n, ntK, c;
    __device__ __forceinline__ void init(int K_, int G_, int first_, int bx) { first = first_; n = G_ - first_; ntK = K_ / BK; c = bx - first_; }
    __device__ __forceinline__ bool next(int i, Unit& u) const {
        if (c < 0) return false; const int t = c + n * i; if (t >= 272) return false;
        u.pm = t >> 3; u.pn = t & 7; u.kt0 = 0; u.ntu = ntK; u.kind = 0; u.slab = 0; u.ui = i; return true;
    }
    __device__ __forceinline__ void a_ready(const Unit&) const {}
    __device__ __forceinline__ void done(const Unit&) const {}
};

template <class Epi, class Sched, bool ALIGN_EPI = false, bool SP2 = false, int MIDFIX = 0>
__device__ __forceinline__ void gemm_phase(LAS unsigned char* lds, int wid_in, const Gemm g, const Sched& S, const Epi& E, float* slabs = nullptr, unsigned* flags = nullptr) {
    int lane_ = __builtin_amdgcn_mbcnt_hi(~0u, __builtin_amdgcn_mbcnt_lo(~0u, 0u)); asm volatile("" : "+v"(lane_));
    const int wid = wid_in, lane = lane_, tid = wid * 64 + lane, wr = wid >> 2, wc = wid & 3, fr = lane & 15, fq = lane >> 4;
    const int K = g.K;
    unsigned voffA[2], voffB[2];
#pragma unroll
    for (int i = 0; i < 2; ++i) { int R, C; stage_rc(tid * 16 + i * 8192, R, C); const int Rb = Epi::PERM ? ((R & ~31) + perm32(R & 31)) : R;
        voffA[i] = (unsigned)(R * K + C) * 2u; voffB[i] = (unsigned)(Rb * K + C) * 2u; }
    const size_t kstep = (size_t)(BK * 2);
    const size_t hstep = (size_t)HALF * K * 2;
    const size_t tstep = 2 * hstep;
    const unsigned ldsw = (unsigned)wid * 1024u;
    const int aoff = lds_byte(wr * 64 + fr, fq * 8), boff = lds_byte(wc * 32 + fr, fq * 8);
#define PG8_SA(b, h) (((b) * 2 + (h)) * HTB)
#define PG8_SB(b, h) ((4 + (b) * 2 + (h)) * HTB)
#define PG8_STAGE(bufoff, gbase, voff) do { _Pragma("unroll") for (int _i = 0; _i < 2; ++_i) \
        __builtin_amdgcn_global_load_lds((const unsigned*)((const char*)(gbase) + (voff)[_i]), (LAS unsigned*)(lds + (bufoff) + ldsw + _i * 8192), 16, 0, 0); } while (0)
#define PG8_LDA(dst, b, h) do { _Pragma("unroll") for (int m = 0; m < 4; ++m) _Pragma("unroll") for (int k = 0; k < 2; ++k) dst[m][k] = *(const LAS bf16x8*)(lds + PG8_SA(b, h) + aoff + m * 2048 + k * 1024); } while (0)
#define PG8_LDB(dst, b, h) do { _Pragma("unroll") for (int n = 0; n < 2; ++n) _Pragma("unroll") for (int k = 0; k < 2; ++k) dst[n][k] = *(const LAS bf16x8*)(lds + PG8_SB(b, h) + boff + n * 2048 + k * 1024); } while (0)
#define PG8_MMA(ai, bj, At, Bt) do { __builtin_amdgcn_s_setprio(1); _Pragma("unroll") for (int m = 0; m < 4; ++m) _Pragma("unroll") for (int n = 0; n < 2; ++n) _Pragma("unroll") for (int k = 0; k < 2; ++k) \
        acc[ai][bj][m][n] = __builtin_amdgcn_mfma_f32_16x16x32_bf16(Bt[n][k], At[m][k], acc[ai][bj][m][n], 0, 0, 0); __builtin_amdgcn_s_setprio(0); } while (0)
#define PG8_WAIT_V(n) asm volatile("s_waitcnt vmcnt(" #n ")" ::: "memory")
#define PG8_WAIT_L(n) asm volatile("s_waitcnt lgkmcnt(" #n ")" ::: "memory")
#define PG8_BAR __builtin_amdgcn_s_barrier()
#define PG8_SCHED __builtin_amdgcn_sched_barrier(0)
    Unit cur, nxt; int ui = 0;
    if (!S.next(0, cur)) return;
    f32x4 acc[2][2][4][2];
#pragma unroll
    for (int a = 0; a < 2; ++a)
#pragma unroll
        for (int b = 0; b < 2; ++b)
#pragma unroll
            for (int m = 0; m < 4; ++m)
#pragma unroll
                for (int n = 0; n < 2; ++n) acc[a][b][m][n] = (f32x4){0.f, 0.f, 0.f, 0.f};
    bf16x8 At[4][2], B0[2][2], B1[2][2];
    const char* cA = (const char*)g.A + (size_t)cur.pm * tstep + (size_t)cur.kt0 * kstep; const char* cB = (const char*)g.Bt + (size_t)cur.pn * tstep + (size_t)cur.kt0 * kstep;
    S.a_ready(cur);
    if constexpr (SP2) {
        PG8_STAGE(PG8_SB(0, 0), cB, voffB); PG8_STAGE(PG8_SB(0, 1), cB + hstep, voffB); PG8_STAGE(PG8_SA(0, 0), cA, voffA); PG8_STAGE(PG8_SA(0, 1), cA + hstep, voffA);
        E.pre(lds, S, wid, lane);
        if (wr == 1) PG8_BAR;
        PG8_WAIT_V(2); PG8_BAR;
        PG8_STAGE(PG8_SB(1, 0), cB + kstep, voffB); PG8_STAGE(PG8_SA(1, 0), cA + kstep, voffA); PG8_STAGE(PG8_SB(1, 1), cB + hstep + kstep, voffB);
        PG8_WAIT_V(6); PG8_BAR;
    } else {
        PG8_STAGE(PG8_SB(0, 0), cB, voffB); PG8_STAGE(PG8_SA(0, 0), cA, voffA); PG8_STAGE(PG8_SB(0, 1), cB + hstep, voffB); PG8_STAGE(PG8_SA(0, 1), cA + hstep, voffA);
        if (wr == 1) PG8_BAR;
        PG8_WAIT_V(4); PG8_BAR;
        PG8_STAGE(PG8_SB(1, 0), cB + kstep, voffB); PG8_STAGE(PG8_SA(1, 0), cA + kstep, voffA); PG8_STAGE(PG8_SB(1, 1), cB + hstep + kstep, voffB);
        PG8_WAIT_V(6); PG8_BAR;
    }
    for (;;) {
        const bool has_next = S.next(ui + 1, nxt);
        const char* nA = has_next ? (const char*)g.A + (size_t)nxt.pm * tstep + (size_t)nxt.kt0 * kstep : cA; const char* nB = has_next ? (const char*)g.Bt + (size_t)nxt.pn * tstep + (size_t)nxt.kt0 * kstep : cB;
        const int nt = cur.ntu;
        for (int t = 0; t < nt; t += 2) {
            if constexpr (MIDFIX != 0) { if (t > 0 && cur.kt0 + t == MIDFIX) {
                if (wr == 0) PG8_BAR;
                int lm = __builtin_amdgcn_mbcnt_hi(~0u, __builtin_amdgcn_mbcnt_lo(~0u, 0u)); asm volatile("" : "+v"(lm)); E.mid(acc, cur, wr, wc, lm & 15, lm >> 4);
                if (wr == 1) PG8_BAR; } }
            const bool last = (t == nt - 2);
            const char* a1 = cA + (size_t)(t + 1) * kstep;
            const char* a2 = last ? nA : cA + (size_t)(t + 2) * kstep; const char* b2 = last ? nB : cB + (size_t)(t + 2) * kstep;
            const char* a3 = a2 + kstep; const char* b3 = b2 + kstep;
            if (last && has_next) S.a_ready(nxt);
            if constexpr (SP2) {
            PG8_LDB(B0, 0, 0); PG8_LDB(B1, 0, 1); PG8_SCHED; PG8_LDA(At, 0, 0); PG8_STAGE(PG8_SA(1, 1), a1 + hstep, voffA);
            PG8_WAIT_V(8); PG8_WAIT_L(0); PG8_BAR; PG8_MMA(0, 0, At, B0); PG8_MMA(0, 1, At, B1); PG8_BAR; PG8_SCHED;
            PG8_LDA(At, 0, 1); PG8_STAGE(PG8_SB(0, 0), b2, voffB); PG8_STAGE(PG8_SB(0, 1), b2 + hstep, voffB); PG8_STAGE(PG8_SA(0, 0), a2, voffA);
            PG8_WAIT_V(8); PG8_WAIT_L(0); PG8_BAR; PG8_MMA(1, 0, At, B0); PG8_MMA(1, 1, At, B1); PG8_BAR; PG8_SCHED;
            PG8_LDB(B0, 1, 0); PG8_LDB(B1, 1, 1); PG8_SCHED; PG8_LDA(At, 1, 0); PG8_STAGE(PG8_SA(0, 1), a2 + hstep, voffA);
            PG8_WAIT_V(8); PG8_WAIT_L(0); PG8_BAR; PG8_MMA(0, 0, At, B0); PG8_MMA(0, 1, At, B1); PG8_BAR; PG8_SCHED;
            PG8_LDA(At, 1, 1); PG8_STAGE(PG8_SB(1, 0), b3, voffB); PG8_STAGE(PG8_SB(1, 1), b3 + hstep, voffB); PG8_STAGE(PG8_SA(1, 0), a3, voffA);
            PG8_WAIT_V(8); PG8_WAIT_L(0); PG8_BAR; PG8_MMA(1, 0, At, B0); PG8_MMA(1, 1, At, B1); PG8_BAR; PG8_SCHED;
            } else {
            PG8_LDB(B0, 0, 0); PG8_SCHED; PG8_LDA(At, 0, 0); PG8_STAGE(PG8_SA(1, 1), a1 + hstep, voffA);
            PG8_WAIT_L(8); PG8_BAR; PG8_WAIT_L(0); PG8_MMA(0, 0, At, B0); PG8_BAR; PG8_SCHED;
            PG8_LDB(B1, 0, 1); PG8_STAGE(PG8_SB(0, 0), b2, voffB);
            PG8_BAR; PG8_WAIT_L(0); PG8_MMA(0, 1, At, B1); PG8_BAR;
            PG8_LDA(At, 0, 1); PG8_STAGE(PG8_SA(0, 0), a2, voffA);
            PG8_BAR; PG8_WAIT_L(0); PG8_MMA(1, 0, At, B0); PG8_BAR; PG8_SCHED;
            PG8_STAGE(PG8_SB(0, 1), b2 + hstep, voffB);
            PG8_WAIT_V(6); PG8_BAR; PG8_MMA(1, 1, At, B1); PG8_BAR;
            PG8_LDB(B0, 1, 0); PG8_SCHED; PG8_LDA(At, 1, 0); PG8_STAGE(PG8_SA(0, 1), a2 + hstep, voffA);
            PG8_WAIT_L(8); PG8_BAR; PG8_WAIT_L(0); PG8_MMA(0, 0, At, B0); PG8_BAR; PG8_SCHED;
            PG8_LDB(B1, 1, 1); PG8_STAGE(PG8_SB(1, 0), b3, voffB);
            PG8_BAR; PG8_WAIT_L(0); PG8_MMA(0, 1, At, B1); PG8_BAR;
            PG8_LDA(At, 1, 1); PG8_STAGE(PG8_SA(1, 0), a3, voffA);
            PG8_BAR; PG8_WAIT_L(0); PG8_MMA(1, 0, At, B0); PG8_BAR; PG8_SCHED;
            PG8_STAGE(PG8_SB(1, 1), b3 + hstep, voffB);
            PG8_WAIT_V(6); PG8_BAR; PG8_MMA(1, 1, At, B1); PG8_BAR;
            }
        }
        if constexpr (ALIGN_EPI) { if (wr == 0) PG8_BAR; }
        int lane_e = __builtin_amdgcn_mbcnt_hi(~0u, __builtin_amdgcn_mbcnt_lo(~0u, 0u)); asm volatile("" : "+v"(lane_e));
        if constexpr (MIDFIX != 0) { if (cur.kt0 + nt <= MIDFIX) E.mid(acc, cur, wr, wc, lane_e & 15, lane_e >> 4); }
        if (cur.kind == 1) {
            const int tl = wid * 64 + lane_e;
            __amdgpu_buffer_rsrc_t rs_ = __builtin_amdgcn_make_buffer_rsrc((void*)(slabs + (size_t)cur.slab * 32768), 0, 131072, 0x00020000);
#pragma unroll
            for (int a = 0; a < 2; ++a)
#pragma unroll
                for (int b = 0; b < 2; ++b)
#pragma unroll
                    for (int m = 0; m < 4; ++m) { const f32x4 v0 = acc[a][b][m][0], v1 = acc[a][b][m][1];
                        u32x4 w; w.x = cvt_pk_bf16(v0[0], v0[1]); w.y = cvt_pk_bf16(v0[2], v0[3]); w.z = cvt_pk_bf16(v1[0], v1[1]); w.w = cvt_pk_bf16(v1[2], v1[3]);
                        __builtin_amdgcn_raw_buffer_store_b128(w, rs_, (tl + ((a * 2 + b) * 4 + m) * 512) * 16, 0, 16); }
            asm volatile("s_waitcnt vmcnt(0)" ::: "memory"); __builtin_amdgcn_s_barrier(); asm volatile("" ::: "memory");
            if (wid == 0 && lane_e == 0) __hip_atomic_store(flags + cur.slab, 1u, __ATOMIC_RELAXED, __HIP_MEMORY_SCOPE_AGENT);
        } else {
            if (cur.kind == 2) {
                if (wid == 0) { unsigned sp_ = 0; while ((unsigned)__builtin_amdgcn_readfirstlane(__hip_atomic_load(flags + cur.slab, __ATOMIC_RELAXED, __HIP_MEMORY_SCOPE_AGENT)) == 0u) { __builtin_amdgcn_s_sleep(2); if (++sp_ > (1u << 22)) break; }
                    __builtin_amdgcn_fence(__ATOMIC_ACQUIRE, "agent"); asm volatile("s_waitcnt vmcnt(0)" ::: "memory"); }
                asm volatile("" ::: "memory"); __builtin_amdgcn_s_barrier(); asm volatile("" ::: "memory");
            }
            { const int fr_ = lane_e & 15, fq_ = lane_e >> 4, tl = wid * 64 + lane_e;
              const f32x4* part = (cur.kind == 2) ? (const f32x4*)((const u32x4*)(slabs + (size_t)cur.slab * 32768) + tl) : nullptr;
              if constexpr (Epi::HAS_SIDE) {
                  float sv[32]; typename Epi::SideItem st; int sh = 0; const bool hs = E.side_load(cur, wid, lane_e, st, sh, sv);
                  asm volatile("" ::: "memory");
                  if (part) E.template run<true>(acc, cur, wr, wc, fr_, fq_, part); else E.template run<false>(acc, cur, wr, wc, fr_, fq_, part);
                  asm volatile("" ::: "memory");
                  if (hs) E.side_store(st, sh, lane_e, sv);
              } else {
                  if (part) E.template run<true>(acc, cur, wr, wc, fr_, fq_, part); else E.template run<false>(acc, cur, wr, wc, fr_, fq_, part);
              } }
        }
        S.done(cur);
        if (!has_next) break;
#pragma unroll
        for (int a = 0; a < 2; ++a)
#pragma unroll
            for (int b = 0; b < 2; ++b)
#pragma unroll
                for (int m = 0; m < 4; ++m)
#pragma unroll
                    for (int n = 0; n < 2; ++n) acc[a][b][m][n] = (f32x4){0.f, 0.f, 0.f, 0.f};
        cur = nxt; cA = nA; cB = nB; ++ui;
        if constexpr (ALIGN_EPI) { if (wr == 1) PG8_BAR; }
    }
    PG8_WAIT_V(0);
    if constexpr (!ALIGN_EPI) { if (wr == 0) PG8_BAR; }
    PG8_BAR;
#undef PG8_SA
#undef PG8_SB
#undef PG8_STAGE
#undef PG8_LDA
#undef PG8_LDB
#undef PG8_MMA
#undef PG8_WAIT_V
#undef PG8_WAIT_L
#undef PG8_BAR
#undef PG8_SCHED
}
}
using pg8::Unit;

__device__ __forceinline__ int swap23(int d) { return (d & 3) | (((d >> 3) & 1) << 2) | (((d >> 2) & 1) << 3); }
template <int MAP> __device__ __forceinline__ int dst_row(int n) {
    if (MAP == 0) return n;
    if (MAP == 1) { if (n < DFF) return 256 * (n >> 7) + (n & 127); const int q = n - DFF; return 256 * (q >> 7) + 128 + (q & 127); }
    if (n < 1024) return 256 * (n >> 7) + (n & 127);
    if (n < 2048) { const int q = n - 1024; return 256 * (q >> 7) + 128 + (q & 127); }
    if (n < 3328) { const int d = n & 63; return d < 16 ? (n & ~63) + swap23(d) : n; }
    return n;
}
struct TItem { const float* W; bf16_t* WT; const float* gain; int K, N, map, item, ldk, koff; };
__device__ __forceinline__ void titem_load(const TItem& t, int lane, float (&v)[64]) {
    const int nblk = t.N / 64, kb = t.item / nblk, nb = t.item % nblk;
    const float* src = t.W + (size_t)(64 * kb) * t.N + 64 * nb + lane;
#pragma unroll
    for (int i = 0; i < 64; ++i) v[i] = __builtin_nontemporal_load(src + (size_t)i * t.N);
}
__device__ __forceinline__ void titem_store(const TItem& t, int lane, float (&v)[64], LAS unsigned char* scr) {
    const int nblk = t.N / 64, kb = t.item / nblk, nb = t.item % nblk, k0 = 64 * kb, n0 = 64 * nb;
    if (t.gain) {
#pragma unroll
        for (int i = 0; i < 64; ++i) v[i] *= t.gain[k0 + i];
    }
#pragma unroll
    for (int c = 0; c < 8; ++c) {
        u32x4 o; o.x = cvt_pk_bf16(v[8 * c], v[8 * c + 1]); o.y = cvt_pk_bf16(v[8 * c + 2], v[8 * c + 3]); o.z = cvt_pk_bf16(v[8 * c + 4], v[8 * c + 5]); o.w = cvt_pk_bf16(v[8 * c + 6], v[8 * c + 7]);
        *(LAS u32x4*)(scr + lane * 144 + c * 16) = o;
    }
    asm volatile("s_waitcnt lgkmcnt(0)" ::: "memory");
#pragma unroll
    for (int j = 0; j < 8; ++j) {
        const int col = (lane >> 3) + 8 * j, c = lane & 7, n = n0 + col;
        const u32x4 o = *(const LAS u32x4*)(scr + col * 144 + c * 16);
        const int r = t.map == 0 ? dst_row<0>(n) : (t.map == 1 ? dst_row<1>(n) : dst_row<2>(n));
        *(u32x4*)(t.WT + (size_t)r * t.ldk + t.koff + k0 + 8 * c) = o;
    }
    asm volatile("s_waitcnt lgkmcnt(0)" ::: "memory");
}

__device__ __forceinline__ void titem_load_half(const TItem& t, int half, int lane, float (&v)[32]) {
    const int nblk = t.N / 64, kb = t.item / nblk, nb = t.item % nblk;
    const float* src = t.W + (size_t)(64 * kb + 32 * half) * t.N + 64 * nb + lane;
#pragma unroll
    for (int i = 0; i < 32; ++i) v[i] = __builtin_nontemporal_load(src + (size_t)i * t.N);
}
__device__ __forceinline__ void titem_store_direct(const TItem& t, int half, int lane, float (&v)[32]) {
    const int nblk = t.N / 64, kb = t.item / nblk, nb = t.item % nblk, k0 = 64 * kb + 32 * half, n = 64 * nb + lane;
    if (t.gain) {
#pragma unroll
        for (int i = 0; i < 32; ++i) v[i] *= t.gain[k0 + i];
    }
    const int r = t.map == 0 ? dst_row<0>(n) : (t.map == 1 ? dst_row<1>(n) : dst_row<2>(n));
    bf16_t* dst = t.WT + (size_t)r * t.ldk + t.koff + k0;
#pragma unroll
    for (int c = 0; c < 4; ++c) {
        u32x4 o; o.x = cvt_pk_bf16(v[8 * c], v[8 * c + 1]); o.y = cvt_pk_bf16(v[8 * c + 2], v[8 * c + 3]); o.z = cvt_pk_bf16(v[8 * c + 4], v[8 * c + 5]); o.w = cvt_pk_bf16(v[8 * c + 6], v[8 * c + 7]);
        *(u32x4*)(dst + 8 * c) = o;
    }
}
struct SideWork {
    const float *w_d1, *w_co, *w_ao, *w_out; unsigned char* ws; int n_items, G, bx;
    __device__ __forceinline__ bool pick(int ui, int wid, TItem& t, int& half) const {
        const int hq = (ui * G + bx) * NWAVES + wid; if (hq >= 2 * n_items) return false; const int q = hq >> 1; half = hq & 1;
        constexpr int I_D = (DFF / 64) * (DM / 64), I_C = (DCONV / 64) * (DM / 64);
        int r = q;
        if (r < I_D) { t = TItem{w_d1, (bf16_t*)(ws + WS_WD1), nullptr, DFF, DM, 0, r, DFF, 0}; return true; } r -= I_D;
        if (r < I_C) { t = TItem{w_co, (bf16_t*)(ws + WS_WCO), nullptr, DCONV, DM, 0, r, DM, 0}; return true; } r -= I_C;
        if (r < I_C) { t = TItem{w_ao, (bf16_t*)(ws + WS_WCO), nullptr, QW, DM, 0, r, DM, DCONV}; return true; } r -= I_C;
        t = TItem{w_out, (bf16_t*)(ws + WS_WOUT), nullptr, DM, DM, 0, r, DM, 0}; return true;
    }
};
constexpr int SIDE_ITEMS = (DFF / 64) * (DM / 64) + 2 * (DCONV / 64) * (DM / 64) + (DM / 64) * (DM / 64);
static_assert(2 * SIDE_ITEMS <= 5 * 256 * NWAVES, "side items must fit the slots every workgroup has");

constexpr int RST_OFF = 131072 + 1024, RST_MAXU = 7;
template <class Sched> __device__ __forceinline__ void build_rs_table(LAS unsigned char* lds, const Sched& S, const float* part, int wave, int lane) {
    LAS float* T = (LAS float*)(lds + RST_OFF);
    const int t = wave * 64 + lane, row = t >> 1, half = t & 1;
    Unit u; float sv[RST_MAXU];
#pragma unroll
    for (int i = 0; i < RST_MAXU; ++i) { sv[i] = 0.f;
        if (S.next(i, u)) { const f32x4* p = (const f32x4*)(part + (size_t)(u.pm * 256 + row) * 32 + half * 16);
            const f32x4 a = p[0], b = p[1], c = p[2], d = p[3]; const f32x4 q = (a + b) + (c + d); sv[i] = (q[0] + q[1]) + (q[2] + q[3]); } }
#pragma unroll
    for (int i = 0; i < RST_MAXU; ++i) { float sq = sv[i]; sq += __shfl_xor(sq, 1); if (half == 0) T[i * 256 + row] = rsqrtf(sq * (1.0f / DM) + EPS); }
    __syncthreads();
}
__device__ __forceinline__ void load_rs(const LAS float* lds_tab_unit, int rloc, float (&rs)[2][4]) {
#pragma unroll
    for (int ai = 0; ai < 2; ++ai)
#pragma unroll
        for (int m = 0; m < 4; ++m) rs[ai][m] = lds_tab_unit[rloc + ai * 128 + m * 16];
}

__device__ __forceinline__ f32x4 slab_half(const u32x4* sp, int piece, int n) {
    const u32x4 w = sp[piece * 512]; const unsigned lo = n ? w.z : w.x, hi = n ? w.w : w.y;
    return (f32x4){bf2f(lo & 0xffffu), __uint_as_float(lo & 0xffff0000u), bf2f(hi & 0xffffu), __uint_as_float(hi & 0xffff0000u)};
}
#define ACCP(ai, bj, m, n) (HP ? acc[ai][bj][m][n] + slab_half((const u32x4*)slabp, (((ai) * 2 + (bj)) * 4 + (m)), (n)) : acc[ai][bj][m][n])

struct EpiSwiGLU {
    static constexpr bool HAS_SIDE = true;
    typedef TItem SideItem;
    SideWork sw;
    __device__ __forceinline__ bool side_load(const Unit& u, int wid, int lane, TItem& t, int& half, float (&v)[32]) const { if (!sw.pick(u.ui, wid, t, half)) return false; titem_load_half(t, half, lane, v); return true; }
    __device__ __forceinline__ void side_store(const TItem& t, int half, int lane, float (&v)[32]) const { titem_store_direct(t, half, lane, v); }
    const float* ss_src;
    template <class Sched> __device__ __forceinline__ void pre(LAS unsigned char* l, const Sched& S, int wave, int lane) const { build_rs_table(l, S, ss_src, wave, lane); }
    static constexpr bool PERM = true, AFTER_DRAIN = false;
    bf16_t* H; const LAS float* part;
    template <bool HP> __device__ __forceinline__ void run(const f32x4 (&acc)[2][2][4][2], const Unit& u, int wr, int wc, int fr, int fq, const f32x4* slabp) const {
        const int row0 = u.pm * 256 + wr * 64 + fr, col0 = u.pn * 128 + wc * 32 + 8 * fq;
        float rs[2][4]; load_rs(part + u.ui * 256, wr * 64 + fr, rs);
#pragma unroll
        for (int ai = 0; ai < 2; ++ai)
#pragma unroll
            for (int m = 0; m < 4; ++m) {
                const float r = rs[ai][m]; float h[8];
#pragma unroll
                for (int n = 0; n < 2; ++n)
#pragma unroll
                    for (int j = 0; j < 4; ++j) { const float g = acc[ai][0][m][n][j] * r, uu = acc[ai][1][m][n][j] * r; h[n * 4 + j] = g * fsigmoid(g) * uu; }
                u32x4 w; w.x = cvt_pk_bf16(h[0], h[1]); w.y = cvt_pk_bf16(h[2], h[3]); w.z = cvt_pk_bf16(h[4], h[5]); w.w = cvt_pk_bf16(h[6], h[7]);
                *(u32x4*)(H + (size_t)(row0 + ai * 128 + m * 16) * DFF + col0) = w;
            }
    }
};

struct EpiResid {
    static constexpr bool HAS_SIDE = false;
    template <class Sched> __device__ __forceinline__ void pre(LAS unsigned char*, const Sched&, int, int) const {}
    static constexpr bool PERM = true, AFTER_DRAIN = false;
    bf16_t* xb; float* part_out; float scale;
    template <bool HP> __device__ __forceinline__ void run(const f32x4 (&acc)[2][2][4][2], const Unit& u, int wr, int wc, int fr, int fq, const f32x4* slabp) const {
        const int row0 = u.pm * 256 + wr * 64 + fr, col0 = u.pn * 256 + wc * 32 + 8 * fq;
        constexpr int MB = HP ? 2 : 4;
#pragma unroll
        for (int ai = 0; ai < 2; ++ai)
#pragma unroll
          for (int mh = 0; mh < 4 / MB; ++mh) {
            u32x4 xi[MB][2];
#pragma unroll
            for (int ml = 0; ml < MB; ++ml)
#pragma unroll
                for (int bj = 0; bj < 2; ++bj) xi[ml][bj] = *(const u32x4*)(xb + (size_t)(row0 + ai * 128 + (mh * MB + ml) * 16) * DM + col0 + bj * 128);
#pragma unroll
            for (int ml = 0; ml < MB; ++ml) {
                const int m = mh * MB + ml, row = row0 + ai * 128 + m * 16; float ss = 0.f;
#pragma unroll
                for (int bj = 0; bj < 2; ++bj) {
                    const u32x4 xw = xi[ml][bj]; const f32x4 a0 = ACCP(ai, bj, m, 0), a1 = ACCP(ai, bj, m, 1); float o[8];
#pragma unroll
                    for (int q = 0; q < 4; ++q) {
                        o[2 * q] = bf2f(xw[q] & 0xffffu) + (q < 2 ? a0 : a1)[(q & 1) * 2] * scale;
                        o[2 * q + 1] = __uint_as_float(xw[q] & 0xffff0000u) + (q < 2 ? a0 : a1)[(q & 1) * 2 + 1] * scale;
                        ss += o[2 * q] * o[2 * q] + o[2 * q + 1] * o[2 * q + 1];
                    }
                    u32x4 w; w.x = cvt_pk_bf16(o[0], o[1]); w.y = cvt_pk_bf16(o[2], o[3]); w.z = cvt_pk_bf16(o[4], o[5]); w.w = cvt_pk_bf16(o[6], o[7]);
                    *(u32x4*)(xb + (size_t)row * DM + col0 + bj * 128) = w;
                }
                ss += __shfl_xor(ss, 16); ss += __shfl_xor(ss, 32);
                if (fq == 0) part_out[(size_t)row * 32 + u.pn * 4 + wc] = ss;
            }
            asm volatile("" ::: "memory");
          }
    }
};

struct EpiBf16 {
    static constexpr bool HAS_SIDE = false;
    template <class Sched> __device__ __forceinline__ void pre(LAS unsigned char*, const Sched&, int, int) const {}
    static constexpr bool PERM = true, AFTER_DRAIN = false;
    bf16_t* C;
    template <bool HP> __device__ __forceinline__ void run(const f32x4 (&acc)[2][2][4][2], const Unit& u, int wr, int wc, int fr, int fq, const f32x4* slabp) const {
        const int row0 = u.pm * 256 + wr * 64 + fr, col0 = u.pn * 256 + wc * 32 + 8 * fq;
#pragma unroll
        for (int ai = 0; ai < 2; ++ai)
#pragma unroll
            for (int m = 0; m < 4; ++m) { bf16_t* rowp = C + (size_t)(row0 + ai * 128 + m * 16) * DM + col0;
#pragma unroll
                for (int bj = 0; bj < 2; ++bj) { const f32x4 v0 = acc[ai][bj][m][0], v1 = acc[ai][bj][m][1];
                    u32x4 w; w.x = cvt_pk_bf16(v0[0], v0[1]); w.y = cvt_pk_bf16(v0[2], v0[3]); w.z = cvt_pk_bf16(v1[0], v1[1]); w.w = cvt_pk_bf16(v1[2], v1[3]);
                    *(u32x4*)(rowp + bj * 128) = w; } }
    }
};

struct EpiPle {
    static constexpr bool HAS_SIDE = false;
    const float* ss_src;
    template <class Sched> __device__ __forceinline__ void pre(LAS unsigned char* l, const Sched& S, int wave, int lane) const { build_rs_table(l, S, ss_src, wave, lane); }
    static constexpr bool PERM = true, AFTER_DRAIN = false;
    bf16_t* X; const bf16_t* xb; const bf16_t* proj; const LAS float* part_in; float* part_out;
    template <bool HP> __device__ __forceinline__ void run(const f32x4 (&acc)[2][2][4][2], const Unit& u, int wr, int wc, int fr, int fq, const f32x4* slabp) const {
        const int row0 = u.pm * 256 + wr * 64 + fr, col0 = u.pn * 256 + wc * 32 + 8 * fq;
        const LAS float* rst = part_in + u.ui * 256 + wr * 64 + fr;
#pragma unroll
        for (int ai = 0; ai < 2; ++ai)
#pragma unroll
          for (int mh = 0; mh < 2; ++mh) {
            u32x4 xi[2][2], pj[2][2];
#pragma unroll
            for (int ml = 0; ml < 2; ++ml)
#pragma unroll
                for (int bj = 0; bj < 2; ++bj) { const size_t off = (size_t)(row0 + ai * 128 + (mh * 2 + ml) * 16) * DM + col0 + bj * 128; xi[ml][bj] = *(const u32x4*)(xb + off); pj[ml][bj] = *(const u32x4*)(proj + off); }
#pragma unroll
            for (int ml = 0; ml < 2; ++ml) {
                const int m = mh * 2 + ml, row = row0 + ai * 128 + m * 16; const float r = rst[ai * 128 + m * 16]; float ss = 0.f;
#pragma unroll
                for (int bj = 0; bj < 2; ++bj) {
                    const u32x4 xw = xi[ml][bj], pw = pj[ml][bj]; const f32x4 a0 = ACCP(ai, bj, m, 0), a1 = ACCP(ai, bj, m, 1); float o[8];
#pragma unroll
                    for (int q = 0; q < 4; ++q) {
                        o[2 * q] = bf2f(xw[q] & 0xffffu) + fsigmoid((q < 2 ? a0 : a1)[(q & 1) * 2] * r) * bf2f(pw[q] & 0xffffu);
                        o[2 * q + 1] = __uint_as_float(xw[q] & 0xffff0000u) + fsigmoid((q < 2 ? a0 : a1)[(q & 1) * 2 + 1] * r) * __uint_as_float(pw[q] & 0xffff0000u);
                        ss += o[2 * q] * o[2 * q] + o[2 * q + 1] * o[2 * q + 1];
                    }
                    u32x4 w; w.x = cvt_pk_bf16(o[0], o[1]); w.y = cvt_pk_bf16(o[2], o[3]); w.z = cvt_pk_bf16(o[4], o[5]); w.w = cvt_pk_bf16(o[6], o[7]);
                    *(u32x4*)(X + (size_t)row * DM + col0 + bj * 128) = w;
                }
                ss += __shfl_xor(ss, 16); ss += __shfl_xor(ss, 32);
                if (fq == 0) part_out[(size_t)row * 32 + u.pn * 4 + wc] = ss;
            }
            asm volatile("" ::: "memory");
          }
    }
};

struct EpiMerge {
    static constexpr bool HAS_SIDE = false;
    template <class Sched> __device__ __forceinline__ void pre(LAS unsigned char*, const Sched&, int, int) const {}
    static constexpr bool PERM = true, AFTER_DRAIN = false;
    const bf16_t* GA; const bf16_t* GB; bf16_t* MG;
    __device__ __forceinline__ void mid(f32x4 (&acc)[2][2][4][2], const Unit& u, int wr, int wc, int fr, int fq) const {
        const int row0 = u.pm * 256 + wr * 64 + fr, col0 = u.pn * 256 + wc * 32 + 8 * fq;
#pragma unroll
        for (int ai = 0; ai < 2; ++ai) {
#pragma unroll
            for (int m = 0; m < 4; ++m) {
#pragma unroll
                for (int bj = 0; bj < 2; ++bj) {
                    const size_t off = (size_t)(row0 + ai * 128 + m * 16) * DM + col0 + bj * 128;
                    const u32x4 aw = *(const u32x4*)(GA + off), bw = *(const u32x4*)(GB + off);
#pragma unroll
                    for (int q = 0; q < 4; ++q) {
                        const float a0 = bf2f(aw[q] & 0xffffu), a1 = __uint_as_float(aw[q] & 0xffff0000u);
                        const float b0 = fmaxf(bf2f(bw[q] & 0xffffu), 1e-30f), b1 = fmaxf(__uint_as_float(bw[q] & 0xffff0000u), 1e-30f);
                        acc[ai][bj][m][q >> 1][(q & 1) * 2] *= a0 * __builtin_amdgcn_rcpf(b0);
                        acc[ai][bj][m][q >> 1][(q & 1) * 2 + 1] *= a1 * __builtin_amdgcn_rcpf(b1);
                    }
                }
            }
            asm volatile("" ::: "memory");
        }
    }
    template <bool HP> __device__ __forceinline__ void run(const f32x4 (&acc)[2][2][4][2], const Unit& u, int wr, int wc, int fr, int fq, const f32x4* slabp) const {
        const int row0 = u.pm * 256 + wr * 64 + fr, col0 = u.pn * 256 + wc * 32 + 8 * fq;
#pragma unroll
        for (int ai = 0; ai < 2; ++ai) {
#pragma unroll
            for (int m = 0; m < 4; ++m) {
#pragma unroll
                for (int bj = 0; bj < 2; ++bj) {
                    const size_t off = (size_t)(row0 + ai * 128 + m * 16) * DM + col0 + bj * 128;
                    const u32x4 bw = *(const u32x4*)(GB + off);
                    const f32x4 av0 = ACCP(ai, bj, m, 0), av1 = ACCP(ai, bj, m, 1); float o[8];
#pragma unroll
                    for (int q = 0; q < 4; ++q) {
                        const float b0 = fmaxf(bf2f(bw[q] & 0xffffu), 1e-30f), b1 = fmaxf(__uint_as_float(bw[q] & 0xffff0000u), 1e-30f);
                        o[2 * q] = b0 * (q < 2 ? av0 : av1)[(q & 1) * 2]; o[2 * q + 1] = b1 * (q < 2 ? av0 : av1)[(q & 1) * 2 + 1];
                    }
                    u32x4 w; w.x = cvt_pk_bf16(o[0], o[1]); w.y = cvt_pk_bf16(o[2], o[3]); w.z = cvt_pk_bf16(o[4], o[5]); w.w = cvt_pk_bf16(o[6], o[7]);
                    *(u32x4*)(MG + off) = w;
                }
                if (HP && (m & 1)) asm volatile("" ::: "memory");
            }
            asm volatile("" ::: "memory");
        }
    }
};

__device__ constexpr float RV_HI[8] = {1.591549367e-01f, 3.086376376e-02f, 5.985185504e-03f, 1.160663669e-03f, 2.250790858e-04f, 4.364795313e-05f, 8.464330676e-06f, 1.641426252e-06f};
__device__ constexpr float RV_LO[8] = {6.420638243e-09f, -3.597993847e-10f, 2.087540557e-10f, -2.775752544e-11f, -6.755001072e-12f, -3.416928741e-13f, 1.318804142e-13f, 1.098673646e-14f};
struct EpiIn {
    static constexpr bool HAS_SIDE = false;
    const float* ss_src;
    template <class Sched> __device__ __forceinline__ void pre(LAS unsigned char* l, const Sched& S, int wave, int lane) const { build_rs_table(l, S, ss_src, wave, lane); }
    static constexpr bool PERM = true, AFTER_DRAIN = false;
    const LAS float* part; bf16_t *U, *Q, *Kb, *Vb, *GA, *GB; const float *cosT, *sinT; float* out;
    template <bool HP> __device__ __forceinline__ void run(const f32x4 (&acc)[2][2][4][2], const Unit& u, int wr, int wc, int fr, int fq, const f32x4* slabp) const {
        const int row0 = u.pm * 256 + wr * 64 + fr, pn = u.pn;
        float rs[2][4]; load_rs(part + u.ui * 256, wr * 64 + fr, rs);
        const bool samp = u.pm >= 32;
        if (pn < 8) {
            const int ch0 = pn * 128 + wc * 32 + 8 * fq;
#pragma unroll
            for (int ai = 0; ai < 2; ++ai)
#pragma unroll
                for (int m = 0; m < 4; ++m) {
                    const int row = row0 + ai * 128 + m * 16; const float r = rs[ai][m]; float h[8];
#pragma unroll
                    for (int n = 0; n < 2; ++n)
#pragma unroll
                        for (int j = 0; j < 4; ++j) h[n * 4 + j] = (acc[ai][0][m][n][j] * r) * fsigmoid(acc[ai][1][m][n][j] * r);
                    u32x4 w; w.x = cvt_pk_bf16(h[0], h[1]); w.y = cvt_pk_bf16(h[2], h[3]); w.z = cvt_pk_bf16(h[4], h[5]); w.w = cvt_pk_bf16(h[6], h[7]);
                    *(u32x4*)(U + (size_t)urow(row) * DCONV + ch0) = w;
                    float* dst = nullptr;
                    if (!samp) { const int t = row & (SEQ - 1), b = row >> 12; if (t >= SEQ - 30) dst = out + OFF_CP + (size_t)(b * 30 + t - (SEQ - 30)) * DCONV + ch0; }
                    else { const int sr = row - MP, t = sr & 63, b = sr >> 6; if (t >= DSEQ - 30) dst = out + OFF_CS + (size_t)(b * 30 + t - (DSEQ - 30)) * DCONV + ch0; }
                    if (dst) { *(f32x4*)dst = (f32x4){h[0], h[1], h[2], h[3]}; *(f32x4*)(dst + 4) = (f32x4){h[4], h[5], h[6], h[7]}; }
                }
        } else if (pn < 13) {
            const bool isq = pn < 12;
            bf16_t* O = isq ? Q : Kb; const int ld = isq ? QW : KVW; const int tcol = isq ? (pn - 8) * 256 : 0;
            const bool rot = ((wc & 1) == 0) && (fq < 2);
            const float qs = isq ? 0.125f : 1.0f;
#pragma unroll
            for (int ai = 0; ai < 2; ++ai)
#pragma unroll
                for (int m = 0; m < 4; ++m) {
                    const int row = row0 + ai * 128 + m * 16; const float r = rs[ai][m] * qs;
                    int pidx, t, b; if (!samp) { t = row & (SEQ - 1); b = row >> 12; pidx = t; } else { const int sr = row - MP; t = sr & 63; b = sr >> 6; pidx = SEQ + t; }
                    float* kdst = nullptr;
                    if (!isq) { if (!samp) { if (t >= SEQ - WIN) kdst = out + OFF_KP + (size_t)(b * WIN + t - (SEQ - WIN)) * KVW; } else kdst = out + OFF_KS + (size_t)(b * WIN + 64 + t) * KVW; }
                    f32x4 cs = (f32x4){1.f, 1.f, 1.f, 1.f}, sn = (f32x4){0.f, 0.f, 0.f, 0.f};
                    if (rot) {
                        const float pf = (float)(pidx < SEQ ? pidx : PAST + (pidx - SEQ));
#pragma unroll
                        for (int j = 0; j < 4; ++j) {
                            const float ch = fq ? RV_HI[4 + j] : RV_HI[j], cl = fq ? RV_LO[4 + j] : RV_LO[j];
                            const float p = pf * ch, e = __builtin_fmaf(pf, ch, -p) + pf * cl;
                            const float rev = (p - __builtin_floorf(p)) + e;
                            cs[j] = __builtin_amdgcn_cosf(rev); sn[j] = __builtin_amdgcn_sinf(rev);
                        }
                    }
#pragma unroll
                    for (int bj = 0; bj < 2; ++bj) {
                        const f32x4 v0 = acc[ai][bj][m][0] * r, v1 = acc[ai][bj][m][1] * r;
                        const int cbase = tcol + bj * 128 + wc * 32;
                        if (rot) {
                            const f32x4 o1 = v0 * cs - v1 * sn, o2 = v1 * cs + v0 * sn;
                            u32x2 w1, w2; w1.x = cvt_pk_bf16(o1[0], o1[1]); w1.y = cvt_pk_bf16(o1[2], o1[3]); w2.x = cvt_pk_bf16(o2[0], o2[1]); w2.y = cvt_pk_bf16(o2[2], o2[3]);
                            *(u32x2*)(O + (size_t)row * ld + cbase + 4 * fq) = w1; *(u32x2*)(O + (size_t)row * ld + cbase + 8 + 4 * fq) = w2;
                            if (kdst) { *(f32x4*)(kdst + cbase + 4 * fq) = o1; *(f32x4*)(kdst + cbase + 8 + 4 * fq) = o2; }
                        } else {
                            u32x4 w; w.x = cvt_pk_bf16(v0[0], v0[1]); w.y = cvt_pk_bf16(v0[2], v0[3]); w.z = cvt_pk_bf16(v1[0], v1[1]); w.w = cvt_pk_bf16(v1[2], v1[3]);
                            *(u32x4*)(O + (size_t)row * ld + cbase + 8 * fq) = w;
                            if (kdst) { *(f32x4*)(kdst + cbase + 8 * fq) = v0; *(f32x4*)(kdst + cbase + 8 * fq + 4) = v1; }
                        }
                    }
                }
        } else if (pn == 13) {
#pragma unroll
            for (int ai = 0; ai < 2; ++ai)
#pragma unroll
                for (int m = 0; m < 4; ++m) {
                    const int row = row0 + ai * 128 + m * 16; const float r = rs[ai][m];
                    float* vdst = nullptr;
                    if (!samp) { const int t = row & (SEQ - 1), b = row >> 12; if (t >= SEQ - WIN) vdst = out + OFF_VP + (size_t)(b * WIN + t - (SEQ - WIN)) * KVW; }
                    else { const int sr = row - MP, t = sr & 63, b = sr >> 6; vdst = out + OFF_VS + (size_t)(b * WIN + 64 + t) * KVW; }
#pragma unroll
                    for (int bj = 0; bj < 2; ++bj) {
                        const f32x4 v0 = acc[ai][bj][m][0] * r, v1 = acc[ai][bj][m][1] * r; const int c = bj * 128 + wc * 32 + 8 * fq;
                        u32x4 w; w.x = cvt_pk_bf16(v0[0], v0[1]); w.y = cvt_pk_bf16(v0[2], v0[3]); w.z = cvt_pk_bf16(v1[0], v1[1]); w.w = cvt_pk_bf16(v1[2], v1[3]);
                        *(u32x4*)(Vb + (size_t)row * KVW + c) = w;
                        if (vdst) { *(f32x4*)(vdst + c) = v0; *(f32x4*)(vdst + c + 4) = v1; }
                    }
                }
        } else {
            bf16_t* O = pn < 22 ? GA : GB; const int tcol = (pn < 22 ? pn - 14 : pn - 22) * 256;
#pragma unroll
            for (int ai = 0; ai < 2; ++ai)
#pragma unroll
                for (int m = 0; m < 4; ++m) {
                    const int row = row0 + ai * 128 + m * 16; const float r = rs[ai][m];
#pragma unroll
                    for (int bj = 0; bj < 2; ++bj) {
                        float h[8];
#pragma unroll
                        for (int n = 0; n < 2; ++n)
#pragma unroll
                            for (int j = 0; j < 4; ++j) h[n * 4 + j] = fsigmoid(acc[ai][bj][m][n][j] * r);
                        u32x4 w; w.x = cvt_pk_bf16(h[0], h[1]); w.y = cvt_pk_bf16(h[2], h[3]); w.z = cvt_pk_bf16(h[4], h[5]); w.w = cvt_pk_bf16(h[6], h[7]);
                        *(u32x4*)(O + (size_t)row * DM + tcol + bj * 128 + wc * 32 + 8 * fq) = w;
                    }
                }
        }
    }
};

#define XB_TMO      128
#define XB_XCNT(j)  (256  + 64 * (j))
#define XB_XSUB(j)  (1280 + 64 * (j))
#define XB_XGEN(j)  (2304 + 64 * (j))
#define XB_TOP      3328
#define XB_TOPGEN   3392
#define XCD_BAR_WORDS 3456
#define XB_SPIN_CAP (1u << 18)
__device__ __forceinline__ unsigned xb_ld(unsigned* p)              { return __hip_atomic_load(p, __ATOMIC_RELAXED, __HIP_MEMORY_SCOPE_AGENT); }
__device__ __forceinline__ unsigned xb_add(unsigned* p, unsigned v) { return __hip_atomic_fetch_add(p, v, __ATOMIC_RELAXED, __HIP_MEMORY_SCOPE_AGENT); }
__device__ __forceinline__ unsigned xb_xcc_id() { return (unsigned)__builtin_amdgcn_s_getreg((3 << 11) | 20) & 0xFu; }
#define XB_SPIN(cond, bar) do { unsigned _sp = 0; while (cond) { __builtin_amdgcn_s_sleep(1); \
    if ((++_sp & 255u) == 0u) { if (xb_ld(&(bar)[XB_TMO])) break; if (_sp > XB_SPIN_CAP) { atomicAdd(&(bar)[XB_TMO], 1u); break; } } } } while (0)
struct XcdBarrier { unsigned* bar; unsigned x; volatile LAS unsigned* st; };
__device__ __forceinline__ bool xb_leader(int wave_id) { return wave_id == 0 && __builtin_amdgcn_mbcnt_hi(~0u, __builtin_amdgcn_mbcnt_lo(~0u, 0u)) == 0u; }
__device__ __forceinline__ XcdBarrier xcd_barrier_post(unsigned* bar, volatile LAS unsigned* st) {
    XcdBarrier b; b.bar = bar; b.x = xb_xcc_id(); b.st = st;
    if (threadIdx.x == 0) (void)xb_add(&bar[XB_XCNT(b.x)], 1u);
    return b;
}
__device__ __forceinline__ void xcd_barrier_complete(unsigned* bar, unsigned x, unsigned& nloc, unsigned& nx) {
    const unsigned G = gridDim.x * gridDim.y * gridDim.z;
    unsigned sum, cnt, mine, sp = 0u;
    for (;;) {
        sum = 0u; cnt = 0u; mine = 0u;
#pragma unroll
        for (unsigned j = 0; j < 16; ++j) { const unsigned c = xb_ld(&bar[XB_XCNT(j)]); sum += c; cnt += (c > 0u) ? 1u : 0u; mine = (j == x) ? c : mine; }
        if (sum == G) break;
        __builtin_amdgcn_s_sleep(1);
        if ((++sp & 255u) == 0u) { if (xb_ld(&bar[XB_TMO])) break; if (sp > XB_SPIN_CAP) { atomicAdd(&bar[XB_TMO], 1u); break; } }
    }
    nloc = mine > 0u ? mine : 1u; nx = cnt > 0u ? cnt : 1u;
}
__device__ __forceinline__ void xcd_barrier(const XcdBarrier& b, int wave_id) {
    asm volatile("s_waitcnt vmcnt(0)" ::: "memory");
    __syncthreads();
    if (xb_leader(wave_id)) {
        unsigned* bar = b.bar;
        __builtin_amdgcn_s_waitcnt(0);
        unsigned nloc = b.st[0], nx = b.st[1];
        if (nloc == 0u) { xcd_barrier_complete(bar, b.x, nloc, nx); b.st[0] = nloc; b.st[1] = nx; }
        const unsigned old = xb_add(&bar[XB_XSUB(b.x)], 1u);
        const unsigned gen = old / nloc;
        if (old + 1u == (gen + 1u) * nloc) {
            __builtin_amdgcn_fence(__ATOMIC_RELEASE, "agent");
            asm volatile("s_waitcnt vmcnt(0)" ::: "memory");
            const unsigned og = xb_add(&bar[XB_TOP], 1u);
            const unsigned tg = og / nx;
            if (og + 1u == (tg + 1u) * nx) xb_add(&bar[XB_TOPGEN], 1u);
            else XB_SPIN(xb_ld(&bar[XB_TOPGEN]) == tg, bar);
            __builtin_amdgcn_fence(__ATOMIC_ACQUIRE, "agent");
            xb_add(&bar[XB_XGEN(b.x)], 1u);
            asm volatile("s_waitcnt vmcnt(0)" ::: "memory");
        } else {
            XB_SPIN(xb_ld(&bar[XB_XGEN(b.x)]) == gen, bar);
            __builtin_amdgcn_fence(__ATOMIC_ACQUIRE, "agent");
            asm volatile("s_waitcnt vmcnt(0)" ::: "memory");
        }
    }
    __syncthreads();
}

#define LDS_WAIT() asm volatile("s_waitcnt lgkmcnt(0)" ::: "memory")
__device__ __forceinline__ float row16_sum(float v) {
    v += __int_as_float(__builtin_amdgcn_update_dpp(0, __float_as_int(v), 0x128, 0xF, 0xF, false));
    v += __int_as_float(__builtin_amdgcn_update_dpp(0, __float_as_int(v), 0x124, 0xF, 0xF, false));
    v += __int_as_float(__builtin_amdgcn_update_dpp(0, __float_as_int(v), 0x122, 0xF, 0xF, false));
    v += __int_as_float(__builtin_amdgcn_update_dpp(0, __float_as_int(v), 0x121, 0xF, 0xF, false));
    return v;
}
__device__ __forceinline__ float wave_sum(float v) {
#pragma unroll
    for (int o = 1; o < 64; o <<= 1) v += __shfl_xor(v, o);
    return v;
}
template <int R, int WI> __device__ __forceinline__ void conv_steps(f32x2 (&y)[R], const f32x2 (&wt)[31], const unsigned* up) {
    const unsigned uv = up[(size_t)WI * (DCONV / 2)];
    const f32x2 a = (f32x2){bf2f(uv & 0xffffu), __uint_as_float(uv & 0xffff0000u)};
    constexpr int lo = WI - 30 > 0 ? WI - 30 : 0, hi = WI < R - 1 ? WI : R - 1;
#pragma unroll
    for (int r = lo; r <= hi; ++r) y[r] += wt[WI - r] * a;
    if constexpr (R > 16 && (WI % 16) == 15) asm volatile("" ::: "memory");
    if constexpr (WI + 1 < R + 30) conv_steps<R, WI + 1>(y, wt, up);
}
template <int R> __device__ __forceinline__ void conv_unit(const unsigned* U32, bf16_t* CAp, LAS float* red, int row0, int tid, int lane, int wave,
                                                           const f32x2 (&wt)[31], f32x2 bv, f32x2 lg, f32x2 lb) {
    constexpr int NS = 2 * R;
    const int ur0 = urow(row0) - 30, c0 = 2 * tid;
    f32x2 y[R];
#pragma unroll
    for (int r = 0; r < R; ++r) y[r] = bv;
    conv_steps<R, 0>(y, wt, U32 + (size_t)ur0 * (DCONV / 2) + tid);
#pragma unroll
    for (int h = 0; h < R; h += 8) {
        float st[16];
#pragma unroll
        for (int r = 0; r < 8; ++r) { st[r] = row16_sum(y[h + r][0] + y[h + r][1]); st[8 + r] = row16_sum(y[h + r][0] * y[h + r][0] + y[h + r][1] * y[h + r][1]); }
        if ((lane & 15) == 0) {
            LAS float* d = red + (wave * 4 + (lane >> 4)) * NS;
            *(LAS f32x4*)(d + h) = (f32x4){st[0], st[1], st[2], st[3]}; *(LAS f32x4*)(d + h + 4) = (f32x4){st[4], st[5], st[6], st[7]};
            *(LAS f32x4*)(d + R + h) = (f32x4){st[8], st[9], st[10], st[11]}; *(LAS f32x4*)(d + R + h + 4) = (f32x4){st[12], st[13], st[14], st[15]};
        }
    }
    __syncthreads();
    constexpr int NP = 32 * NS / 64;
    float tot = 0.f;
#pragma unroll
    for (int p = 0; p < NP; ++p) tot += red[((lane / NS) * NP + p) * NS + (lane % NS)];
    if (NS == 32) tot += __shfl_xor(tot, 32);
    const float s1v = __shfl(tot, lane % R), s2v = __shfl(tot, R + lane % R);
    const float mu_l = s1v * (1.0f / DCONV), var_l = fmaxf(s2v * (1.0f / DCONV) - mu_l * mu_l, 0.f), rstd_l = rsqrtf(var_l + EPS);
#pragma unroll
    for (int r = 0; r < R; ++r) {
        const float mu = __int_as_float(__builtin_amdgcn_readlane(__float_as_int(mu_l), r)), rstd = __int_as_float(__builtin_amdgcn_readlane(__float_as_int(rstd_l), r));
        const float z0 = (y[r][0] - mu) * rstd * lg[0] + lb[0], z1 = (y[r][1] - mu) * rstd * lg[1] + lb[1];
        *(unsigned*)(CAp + (size_t)(row0 + r) * DM + c0) = cvt_pk_bf16(z0 * fsigmoid(z0), z1 * fsigmoid(z1));
    }
}
struct Args { const float* in[27]; float* out; unsigned char* ws; int ph_lo, ph_hi, coop, pad; };

__global__ void __launch_bounds__(NWAVES * 64, 2) mk_fwd(Args args) {
    extern __shared__ __attribute__((aligned(16))) unsigned char lds_raw[];
    LAS unsigned char* lds = (LAS unsigned char*)lds_raw;
    volatile LAS unsigned* MISC = (volatile LAS unsigned*)(lds + MISC_OFF);
    const int wave0 = __builtin_amdgcn_readfirstlane(threadIdx.x >> 6);
    const int G = gridDim.x, bx = blockIdx.x;
#define PHASE_IDS int lane_p = __builtin_amdgcn_mbcnt_hi(~0u, __builtin_amdgcn_mbcnt_lo(~0u, 0u)); asm volatile("" : "+v"(lane_p)); const int lane = lane_p, wave = wave0, tid = wave * 64 + lane; (void)lane; (void)wave; (void)tid
    unsigned char* ws = args.ws; float* out = args.out;
    unsigned* ctl = (unsigned*)(ws + WS_CTL);
    const float* x_p = args.in[0]; const float* x_s = args.in[1]; const float* p_p = args.in[2]; const float* p_s = args.in[3];
    const float* state_conv = args.in[4]; const float* cache_k = args.in[5]; const float* cache_v = args.in[6];
    bf16_t* Wgu1 = (bf16_t*)(ws + WS_WGU1); bf16_t* Wd1 = (bf16_t*)(ws + WS_WD1); bf16_t* Win = (bf16_t*)(ws + WS_WIN);
    bf16_t* Wcat = (bf16_t*)(ws + WS_WCO); bf16_t* Wout = (bf16_t*)(ws + WS_WOUT);
    static_assert(WS_WAO - WS_WCO == (size_t)DM * DCONV * 2 && WS_WOUT - WS_WCO == (size_t)DM * DM * 2, "Wcat");
    bf16_t* Wgu2 = (bf16_t*)(ws + WS_WGU2); bf16_t* Wd2 = (bf16_t*)(ws + WS_WD2); bf16_t* Wpg = (bf16_t*)(ws + WS_WPG); bf16_t* Wpe = (bf16_t*)(ws + WS_WPE);
    bf16_t* XB = (bf16_t*)(ws + WS_XB);
    bf16_t* CAO = (bf16_t*)(ws + WS_WD1);
    static_assert(WS_WCO - WS_WD1 >= (size_t)2 * M * DCONV * 2, "cA | o overlay"); bf16_t* PB = (bf16_t*)(ws + WS_PB);
    float* cosT = (float*)(ws + WS_ROPE); float* sinT = cosT + 4160 * 8;
    float* SS0 = (float*)(ws + WS_SS); float* SS1 = (float*)(ws + WS_SS + SS_BYTES); float* SS2 = (float*)(ws + WS_SS + 2 * SS_BYTES);
    float* SS3 = (float*)(ws + WS_SS + 3 * SS_BYTES); float* SS4 = (float*)(ws + WS_SS + 4 * SS_BYTES);
    unsigned char* R = ws + WS_R;
    bf16_t* HID = (bf16_t*)R; bf16_t* UB = (bf16_t*)(R + R_U); bf16_t* QB = (bf16_t*)(R + R_Q); bf16_t* KB = (bf16_t*)(R + R_K); bf16_t* VB = (bf16_t*)(R + R_V);
    bf16_t* GA = (bf16_t*)(R + R_GA); bf16_t* GB = (bf16_t*)(R + R_GB); bf16_t* MG = (bf16_t*)R;
    static_assert(R_GA >= (size_t)M * DM * 2, "merged overlay");
    bf16_t* PROJ = (bf16_t*)(ws + WS_PROJ);
    float* SLAB = (float*)(ws + WS_SLAB); unsigned* FLAG = ctl + CW_FLAG;

    for (int u = threadIdx.x; u < (LDS_BYTES - LDSCTL_OFF) / 4; u += NWAVES * 64) ((LAS unsigned*)(lds + LDSCTL_OFF))[u] = 0u;
    __syncthreads();
    XcdBarrier bar; bar.bar = ctl + CW_BAR; bar.x = 0; bar.st = nullptr;
    if (args.coop) bar = xcd_barrier_post(ctl + CW_BAR, MISC + 8);
    const int lo = args.ph_lo, hi = args.ph_hi;
#define IN(k) (lo <= (k) && (k) < hi)
#define SEAM(k) do { if (IN(k) && IN((k) + 1)) xcd_barrier(bar, wave0); } while (0)

    constexpr int I_GU = (DM / 64) * (2 * DFF / 64), I_D = (DFF / 64) * (DM / 64), I_IN = (DM / 64) * (INC / 64), I_C = (DCONV / 64) * (DM / 64),
                  I_O = (DM / 64) * (DM / 64), I_PE = (DPLE / 64) * (DM / 64);
#define RUN_ITEMS(PICK, NIT, GW, NGW_) do { float va[64], vb[64]; int it = (GW); \
        if (it < (NIT)) { TItem ta = PICK(it); titem_load(ta, lane, va); \
            for (;;) { const int it2 = it + (NGW_); TItem tb = ta; \
                if (it2 < (NIT)) { tb = PICK(it2); titem_load(tb, lane, vb); } \
                titem_store(ta, lane, va, lds + wave * 9216); \
                if (it2 >= (NIT)) break; \
                const int it3 = it2 + (NGW_); \
                if (it3 < (NIT)) { ta = PICK(it3); titem_load(ta, lane, va); } \
                titem_store(tb, lane, vb, lds + wave * 9216); \
                if (it3 >= (NIT)) break; \
                it = it3; } } } while (0)
    if (IN(0)) {
        PHASE_IDS;
        const int gw = bx * NWAVES + wave, NGW = G * NWAVES;
        const int NITEMS_A = I_GU + I_IN + I_O + I_PE + ((G == 256) ? 0 : I_D + 2 * I_C + I_O);
        auto pick = [&](int it) -> TItem {
            int r = it;
            if (r < I_GU) return TItem{args.in[8], Wgu1, args.in[7], DM, 2 * DFF, 1, r, DM, 0}; r -= I_GU;
            if (r < I_IN) return TItem{args.in[11], Win, args.in[10], DM, INC, 2, r, DM, 0}; r -= I_IN;
            if (r < I_O) return TItem{args.in[24], Wpg, args.in[23], DM, DM, 0, r, DM, 0}; r -= I_O;
            if (r < I_PE) return TItem{args.in[25], Wpe, nullptr, DPLE, DM, 0, r, DPLE, 0}; r -= I_PE;
            if (r < I_D) return TItem{args.in[9], Wd1, nullptr, DFF, DM, 0, r, DFF, 0}; r -= I_D;
            if (r < I_C) return TItem{args.in[16], Wcat, nullptr, DCONV, DM, 0, r, DM, 0}; r -= I_C;
            if (r < I_C) return TItem{args.in[18], Wcat, nullptr, QW, DM, 0, r, DM, DCONV}; r -= I_C;
            return TItem{args.in[19], Wout, nullptr, DM, DM, 0, r, DM, 0};
        };
        RUN_ITEMS(pick, NITEMS_A, gw, NGW);
        for (int row = gw; row < M; row += NGW) {
            const float* xr = row < MP ? x_p + (size_t)row * DM : x_s + (size_t)(row - MP) * DM;
            f32x4 v[8]; float s = 0.f;
#pragma unroll
            for (int j = 0; j < 8; ++j) { v[j] = ((const f32x4*)xr)[lane + 64 * j]; s += (v[j][0] * v[j][0] + v[j][1] * v[j][1]) + (v[j][2] * v[j][2] + v[j][3] * v[j][3]); }
            s = wave_sum(s);
#pragma unroll
            for (int j = 0; j < 8; ++j) { u32x2 w; w.x = cvt_pk_bf16(v[j][0], v[j][1]); w.y = cvt_pk_bf16(v[j][2], v[j][3]); ((u32x2*)(XB + (size_t)row * DM))[lane + 64 * j] = w; }
            if (lane < 32) SS0[(size_t)row * 32 + lane] = (lane == 0) ? s : 0.f;
            const float* pr = row < MP ? p_p + (size_t)row * DPLE : p_s + (size_t)(row - MP) * DPLE;
            const f32x4 pv = ((const f32x4*)pr)[lane]; u32x2 w; w.x = cvt_pk_bf16(pv[0], pv[1]); w.y = cvt_pk_bf16(pv[2], pv[3]);
            ((u32x2*)(PB + (size_t)row * DPLE))[lane] = w;
        }
        for (int e = bx * 512 + tid; e < NBS * 64 * KVW / 4; e += G * 512) {
            const int b = e / (64 * KVW / 4), r = e % (64 * KVW / 4);
            ((f32x4*)(out + OFF_KS + (size_t)b * WIN * KVW))[r] = ((const f32x4*)(cache_k + (size_t)(b * WIN + 64) * KVW))[r];
            ((f32x4*)(out + OFF_VS + (size_t)b * WIN * KVW))[r] = ((const f32x4*)(cache_v + (size_t)(b * WIN + 64) * KVW))[r];
        }
        if (args.coop == 2) { cg::this_grid().sync(); }
        SEAM(0);
    }

    if (IN(1)) {
        pg8::Gemm g{XB, Wgu1, M, 2 * DFF, DM}; pg8::StaticOrder S; S.init(M, 2 * DFF, DM, G, bx);
        EpiSwiGLU E{SideWork{args.in[9], args.in[16], args.in[18], args.in[19], ws, (G == 256) ? SIDE_ITEMS : 0, G, bx}, SS0, HID, (const LAS float*)(lds + RST_OFF)};
        pg8::gemm_phase<EpiSwiGLU, pg8::StaticOrder, true, true>(lds, wave0, g, S, E);
        {
            const int ntiles = (M / 256) * (2 * DFF / 256), full = ntiles / G, first = ntiles - full * G;
            if (bx >= first) {
                PHASE_IDS;
                auto pick2 = [&](int it) -> TItem {
                    if (it < I_GU) return TItem{args.in[21], Wgu2, args.in[20], DM, 2 * DFF, 1, it, DM, 0};
                    return TItem{args.in[22], Wd2, nullptr, DFF, DM, 0, it - I_GU, DFF, 0};
                };
                RUN_ITEMS(pick2, I_GU + I_D, (bx - first) * NWAVES + wave, (G - first) * NWAVES);
            }
        }
        SEAM(1);
    }
    if (IN(2)) {
        pg8::Gemm g{HID, Wd1, M, DM, DFF}; pg8::StreamK S; S.init(DFF, G, bx);
        EpiResid E{XB, SS1, 0.5f};
        pg8::gemm_phase<EpiResid, pg8::StreamK, true, true>(lds, wave0, g, S, E, SLAB, FLAG);
        SEAM(2);
    }
    if (IN(3)) {
        { PHASE_IDS;
        for (int e = bx * 512 + tid; e < (NBP + NBS) * 30 * (DCONV / 2); e += G * 512) {
            const int sq = e / (30 * (DCONV / 2)), rem = e % (30 * (DCONV / 2)), r = rem / (DCONV / 2), c2 = rem % (DCONV / 2);
            unsigned val = 0u; int ur;
            if (sq < NBP) ur = sq * (SEQ + 30) + r;
            else { const int sb = sq - NBP; ur = NBP * (SEQ + 30) + sb * (DSEQ + 30) + r; const f32x2 sv = *(const f32x2*)(state_conv + (size_t)(sb * 30 + r) * DCONV + 2 * c2); val = cvt_pk_bf16(sv[0], sv[1]); }
            ((unsigned*)UB)[(size_t)ur * (DCONV / 2) + c2] = val;
        }
        }
        pg8::Gemm g{XB, Win, M, INC, DM}; pg8::StaticOrder S; S.init(M, INC, DM, G, bx);
        EpiIn E{SS1, (const LAS float*)(lds + RST_OFF), UB, QB, KB, VB, GA, GB, cosT, sinT, out};
        pg8::gemm_phase<EpiIn, pg8::StaticOrder, true, true>(lds, wave0, g, S, E);
        SEAM(3);
    }
    if (IN(4)) {
        PHASE_IDS;
        constexpr int N_ATT = 136 * 4, N_CONV = M / 16;
        for (int item = bx; item < N_ATT; item += G) {
            {
                const bf16_t* KBp = KB; const bf16_t* VBp = VB; const bf16_t* QBp = QB; bf16_t* OBp = CAO + DCONV; const float* ckp = cache_k; const float* cvp = cache_v;
                const int cidx = item >> 2, kvh = item & 3;
                const bool samp = cidx >= 128;
                const int b = samp ? cidx - 128 : cidx >> 6, c = samp ? 2 : (cidx & 63);
                const int qrow0 = samp ? MP + b * 64 : b * SEQ + c * 64;
                LAS bf16_t* Ks = (LAS bf16_t*)lds;
                LAS bf16_t* Vt = (LAS bf16_t*)(lds + 192 * 72 * 2);
#pragma unroll
                for (int it = 0; it < 3; ++it) {
                    const int idx = it * 512 + tid, key = idx >> 3, ch = idx & 7;
                    u32x4 w = (u32x4){0u, 0u, 0u, 0u};
                    if (samp && key < 128) {
                        const float* src = ckp + ((size_t)(b * WIN + key) * 4 + kvh) * 64 + ch * 8;
                        const f32x4 a = *(const f32x4*)src, bb = *(const f32x4*)(src + 4);
                        w.x = cvt_pk_bf16(a[0], a[1]); w.y = cvt_pk_bf16(a[2], a[3]); w.z = cvt_pk_bf16(bb[0], bb[1]); w.w = cvt_pk_bf16(bb[2], bb[3]);
                    } else {
                        const int kc = c - 2 + (key >> 6);
                        if (kc >= 0) { const int grow = samp ? MP + b * 64 + (key - 128) : b * SEQ + kc * 64 + (key & 63);
                            w = *(const u32x4*)(KBp + (size_t)grow * KVW + kvh * 64 + ch * 8); }
                    }
                    *(LAS u32x4*)(Ks + key * 72 + ch * 8) = w;
                }
#pragma unroll
                for (int it = 0; it < 3; ++it) {
                    const int blk = it * 8 + wave, key = (blk % 3) * 64 + lane, j = blk / 3;
                    u32x4 w = (u32x4){0u, 0u, 0u, 0u};
                    if (samp && key < 128) {
                        const float* src = cvp + ((size_t)(b * WIN + key) * 4 + kvh) * 64 + j * 8;
                        const f32x4 a = *(const f32x4*)src, bb = *(const f32x4*)(src + 4);
                        w.x = cvt_pk_bf16(a[0], a[1]); w.y = cvt_pk_bf16(a[2], a[3]); w.z = cvt_pk_bf16(bb[0], bb[1]); w.w = cvt_pk_bf16(bb[2], bb[3]);
                    } else {
                        const int kc = c - 2 + (key >> 6);
                        if (kc >= 0) { const int grow = samp ? MP + b * 64 + (key - 128) : b * SEQ + kc * 64 + (key & 63);
                            w = *(const u32x4*)(VBp + (size_t)grow * KVW + kvh * 64 + j * 8); }
                    }
                    const int kp = (key & ~15) | swap23(key & 15);
#pragma unroll
                    for (int i = 0; i < 4; ++i) { Vt[(8 * j + 2 * i) * 200 + kp] = (bf16_t)(w[i] & 0xffffu); Vt[(8 * j + 2 * i + 1) * 200 + kp] = (bf16_t)(w[i] >> 16); }
                }
                const int r32 = lane & 31, hi = lane >> 5;
                const int head = kvh * 4 + (wave >> 1), qrow = qrow0 + 32 * (wave & 1) + r32;
                bf16x8 qr[4];
#pragma unroll
                for (int ks = 0; ks < 4; ++ks) qr[ks] = *(const bf16x8*)(QBp + (size_t)qrow * QW + head * 64 + ks * 16 + hi * 8);
                const float sink = args.in[17][head];
                __syncthreads();
                f32x16 p[6];
                const int kb0 = samp ? 0 : (c >= 2 ? 0 : (c == 1 ? 2 : 4));
#pragma unroll
                for (int kb = 0; kb < 6; ++kb) {
                    f32x16 a = {};
#pragma unroll
                    for (int ks = 0; ks < 4; ++ks) {
                        const bf16x8 kf = *(const LAS bf16x8*)(Ks + (kb * 32 + r32) * 72 + ks * 16 + hi * 8);
                        a = __builtin_amdgcn_mfma_f32_32x32x16_bf16(kf, qr[ks], a, 0, 0, 0);
                    }
                    p[kb] = a;
                }
                float mx = sink;
#pragma unroll
                for (int kb = 0; kb < 6; ++kb) { if (kb >= kb0) {
#pragma unroll
                    for (int r = 0; r < 16; ++r) mx = fmaxf(mx, p[kb][r]); } }
                mx = fmaxf(mx, __shfl_xor(mx, 32));
                float l = 0.f;
#pragma unroll
                for (int kb = 0; kb < 6; ++kb) {
#pragma unroll
                    for (int r = 0; r < 16; ++r) { const float e = (kb >= kb0) ? __expf(p[kb][r] - mx) : 0.f; p[kb][r] = e; l += e; } }
                l += __shfl_xor(l, 32);
                l += __expf(sink - mx);
                const float rl = 1.0f / l;
                f32x16 o[2] = {{}, {}};
#pragma unroll
                for (int kb = 0; kb < 6; ++kb)
#pragma unroll
                    for (int j = 0; j < 2; ++j) {
                        u32x4 pw; pw.x = cvt_pk_bf16(p[kb][8 * j + 0], p[kb][8 * j + 1]); pw.y = cvt_pk_bf16(p[kb][8 * j + 2], p[kb][8 * j + 3]);
                        pw.z = cvt_pk_bf16(p[kb][8 * j + 4], p[kb][8 * j + 5]); pw.w = cvt_pk_bf16(p[kb][8 * j + 6], p[kb][8 * j + 7]);
                        const bf16x8 pf = __builtin_bit_cast(bf16x8, pw);
#pragma unroll
                        for (int db = 0; db < 2; ++db) {
                            const bf16x8 vf = *(const LAS bf16x8*)(Vt + (db * 32 + r32) * 200 + kb * 32 + j * 16 + hi * 8);
                            o[db] = __builtin_amdgcn_mfma_f32_32x32x16_bf16(vf, pf, o[db], 0, 0, 0);
                        }
                    }
#pragma unroll
                for (int db = 0; db < 2; ++db)
#pragma unroll
                    for (int i = 0; i < 4; ++i) {
                        u32x2 w; w.x = cvt_pk_bf16(o[db][4 * i] * rl, o[db][4 * i + 1] * rl); w.y = cvt_pk_bf16(o[db][4 * i + 2] * rl, o[db][4 * i + 3] * rl);
                        *(u32x2*)(OBp + (size_t)qrow * DM + head * 64 + db * 32 + 8 * i + 4 * hi) = w;
                    }
                __syncthreads();
            }
        }
        {
            const int c0 = 2 * tid;
            f32x2 wt[31];
#pragma unroll
            for (int j = 0; j < 31; ++j) wt[j] = *(const f32x2*)(args.in[12] + (size_t)j * DCONV + c0);
            const f32x2 bv = *(const f32x2*)(args.in[13] + c0), lg = *(const f32x2*)(args.in[14] + c0), lb = *(const f32x2*)(args.in[15] + c0);
            const unsigned* U32 = (const unsigned*)UB;
            LAS float* red = (LAS float*)lds;
            if (G == 256) {
                if (bx < 32) conv_unit<16>(U32, CAO, red, bx * 16, tid, lane, wave, wt, bv, lg, lb);
                else { const int l = bx - 32;
                    conv_unit<32>(U32, CAO, red, (32 + 2 * l) * 16, tid, lane, wave, wt, bv, lg, lb);
                    if (l < 64) conv_unit<16>(U32, CAO, red + 2048, (480 + l) * 16, tid, lane, wave, wt, bv, lg, lb); }
            } else {
                int it = 0;
                for (int cu = bx; cu < N_CONV; cu += G, ++it) conv_unit<16>(U32, CAO, red + (it & 1) * 2048, cu * 16, tid, lane, wave, wt, bv, lg, lb);
            }
            __syncthreads();
        }
        SEAM(4);
    }
    if (IN(5)) {
        pg8::StreamK S; S.init(DM, G, bx);
        pg8::Gemm g{CAO, Wcat, M, DM, DM}; EpiMerge E{GA, GB, MG};
        pg8::gemm_phase<EpiMerge, pg8::StreamK, true, true, 16>(lds, wave0, g, S, E, SLAB, FLAG + 512);
        SEAM(5);
    }
    if (IN(6)) {
        pg8::Gemm g{MG, Wout, M, DM, DM}; pg8::StreamK S; S.init(DM, G, bx);
        EpiResid E{XB, SS2, 1.0f};
        pg8::gemm_phase<EpiResid, pg8::StreamK, true, true>(lds, wave0, g, S, E, SLAB, FLAG + 1536);
        SEAM(6);
    }
    if (IN(7)) {
        pg8::Gemm g{XB, Wgu2, M, 2 * DFF, DM}; pg8::StaticOrder S; S.init(M, 2 * DFF, DM, G, bx);
        EpiSwiGLU E{SideWork{nullptr, nullptr, nullptr, nullptr, ws, 0, G, bx}, SS2, HID, (const LAS float*)(lds + RST_OFF)};
        pg8::gemm_phase<EpiSwiGLU, pg8::StaticOrder, true, true>(lds, wave0, g, S, E);
        {
            const int ntiles = (M / 256) * (2 * DFF / 256), full = ntiles / G, first = ntiles - full * G;
            pg8::Gemm g2{PB, Wpe, M, DM, DPLE}; pg8::SlackOrder S2; S2.init(DPLE, G, first, bx);
            EpiBf16 E2{PROJ};
            pg8::gemm_phase<EpiBf16, pg8::SlackOrder, true, true>(lds, wave0, g2, S2, E2);
        }
        SEAM(7);
    }
    if (IN(8)) {
        pg8::Gemm g{HID, Wd2, M, DM, DFF}; pg8::StreamK S; S.init(DFF, G, bx);
        EpiResid E{XB, SS3, 0.5f};
        pg8::gemm_phase<EpiResid, pg8::StreamK, true, true>(lds, wave0, g, S, E, SLAB, FLAG + 2048);
        SEAM(8);
    }
    if (IN(9)) {
        pg8::Gemm g{XB, Wpg, M, DM, DM}; pg8::StreamK S; S.init(DM, G, bx);
        EpiPle E{SS3, (bf16_t*)R, XB, PROJ, (const LAS float*)(lds + RST_OFF), SS4};
        pg8::gemm_phase<EpiPle, pg8::StreamK, true, true>(lds, wave0, g, S, E, SLAB, FLAG + 2560);
        SEAM(9);
    }
    if (IN(10)) {
        PHASE_IDS;
        const float* fn = args.in[26];
        pg8::StreamK S; S.init(DM, G, bx); pg8::Unit u;
        for (int i = 0; S.next(i, u); ++i) {
            if (u.kind == 1) continue;
            const f32x4 gn = *(const f32x4*)(fn + u.pn * 256 + 4 * lane);
            const f32x4* pp = (const f32x4*)(SS4 + (size_t)(u.pm * 256 + wave * 32 + (lane & 31)) * 32);
            f32x4 a4 = pp[0];
#pragma unroll
            for (int j = 1; j < 8; ++j) a4 += pp[j];
            const float rs_l = rsqrtf(((a4[0] + a4[1]) + (a4[2] + a4[3])) * (1.0f / DM) + EPS);
            const u32x2* q0 = (const u32x2*)((const bf16_t*)R + (size_t)(u.pm * 256 + wave * 32) * DM + u.pn * 256) + lane;
            f32x4* p0 = (f32x4*)(out + (size_t)(u.pm * 256 + wave * 32) * DM + u.pn * 256) + lane;
#pragma unroll
            for (int r0 = 0; r0 < 32; r0 += 8) {
                u32x2 v[8];
#pragma unroll
                for (int k = 0; k < 8; ++k) v[k] = q0[(size_t)(r0 + k) * (DM / 4)];
#pragma unroll
                for (int k = 0; k < 8; ++k) { const float rs = __shfl(rs_l, r0 + k);
                    const f32x4 xv = (f32x4){bf2f(v[k].x & 0xffffu), __uint_as_float(v[k].x & 0xffff0000u), bf2f(v[k].y & 0xffffu), __uint_as_float(v[k].y & 0xffff0000u)};
                    p0[(size_t)(r0 + k) * (DM / 4)] = xv * rs * gn; }
            }
        }
    }
#undef IN
#undef SEAM
}

extern "C" void kernel_launch(void* const* d_in, const int* in_sizes, int n_in, void* d_out, int out_size, void* d_ws, size_t ws_size, hipStream_t stream) {
    static int grid = 0;
    if (grid == 0) {
        if (n_in != 27 || (size_t)out_size != OUT_TOTAL || ws_size < WS_END) {
            fprintf(stderr, "kernel_launch: unexpected shapes: n_in %d out %d ws %zu (need %zu)\n", n_in, out_size, ws_size, (size_t)WS_END); grid = -1; return; }
        int dev = 0, cus = 0, per_cu = 0;
        if (hipGetDevice(&dev) != hipSuccess || hipDeviceGetAttribute(&cus, hipDeviceAttributeMultiprocessorCount, dev) != hipSuccess) { grid = -1; return; }
        if (hipFuncSetAttribute((const void*)mk_fwd, hipFuncAttributeMaxDynamicSharedMemorySize, LDS_BYTES) != hipSuccess) { fprintf(stderr, "kernel_launch: hipFuncSetAttribute failed\n"); grid = -1; return; }
        if (hipOccupancyMaxActiveBlocksPerMultiprocessor(&per_cu, (const void*)mk_fwd, NWAVES * 64, LDS_BYTES) != hipSuccess || per_cu < 1) { fprintf(stderr, "kernel_launch: occupancy query failed (%d)\n", per_cu); (void)hipGetLastError(); grid = -1; return; }
        grid = cus * 1;
    }
    if (grid < 0) return;
    (void)hipMemsetAsync((char*)d_ws + WS_CTL, 0, CTL_ZERO_BYTES, stream);
    Args a{};
    for (int i = 0; i < 27; ++i) a.in[i] = (const float*)d_in[i];
    a.out = (float*)d_out; a.ws = (unsigned char*)d_ws;
#if MK_N_LAUNCHES == 1
    a.ph_lo = 0; a.ph_hi = 11; a.coop = 1;
    void* kargs[] = {&a};
    hipError_t e = hipLaunchCooperativeKernel((const void*)mk_fwd, dim3(grid), dim3(NWAVES * 64), kargs, LDS_BYTES, stream);
    if (e != hipSuccess) fprintf(stderr, "cooperative launch failed: %s (grid %d)\n", hipGetErrorString(e), grid);
#else
    for (int ph = 0; ph < 11; ++ph) {
        a.ph_lo = ph; a.ph_hi = ph + 1; a.coop = 0;
        hipLaunchKernelGGL(mk_fwd, dim3(grid), dim3(NWAVES * 64), LDS_BYTES, stream, a);
    }
#endif
}
```

```cpp
#include <hip/hip_runtime.h>
#include <hip/hip_cooperative_groups.h>
#include <cstdio>
#include <cstdint>
namespace cg = cooperative_groups;

#ifndef MK_N_LAUNCHES
#define MK_N_LAUNCHES 1
#endif

#define GAS __attribute__((address_space(1)))
#define LAS __attribute__((address_space(3)))
typedef unsigned short bf16_t;
typedef short bf16x8 __attribute__((ext_vector_type(8)));
typedef float f32x4 __attribute__((ext_vector_type(4)));
typedef float f32x2 __attribute__((ext_vector_type(2)));
typedef float f32x16 __attribute__((ext_vector_type(16)));
typedef unsigned u32x4 __attribute__((ext_vector_type(4)));
typedef unsigned u32x2 __attribute__((ext_vector_type(2)));

constexpr int DM = 2048, DFF = 5504, DCONV = 1024, QW = 1024, KVW = 256, INC = 7680, DPLE = 256;
constexpr int SEQ = 4096, DSEQ = 64, NBP = 2, NBS = 8, CW = 31, WIN = 128;
constexpr int MP = NBP * SEQ, MS = NBS * DSEQ, M = MP + MS;
constexpr int PAST = 1024;
constexpr float EPS = 1e-6f;
constexpr size_t OFF_Y = 0;
constexpr size_t OFF_KP = (size_t)M * DM;
constexpr size_t OFF_VP = OFF_KP + (size_t)NBP * WIN * KVW;
constexpr size_t OFF_CP = OFF_VP + (size_t)NBP * WIN * KVW;
constexpr size_t OFF_KS = OFF_CP + (size_t)NBP * 30 * DCONV;
constexpr size_t OFF_VS = OFF_KS + (size_t)NBS * WIN * KVW;
constexpr size_t OFF_CS = OFF_VS + (size_t)NBS * WIN * KVW;
constexpr size_t OUT_TOTAL = OFF_CS + (size_t)NBS * 30 * DCONV;

constexpr size_t MiB = 1u << 20;
constexpr size_t al(size_t x) { return (x + 4095) & ~(size_t)4095; }
constexpr size_t WS_CTL = 0, CTL_ZERO_BYTES = 64 * 1024;
constexpr size_t WS_WGU1 = 1 * MiB;
constexpr size_t WS_WD1 = WS_WGU1 + al((size_t)2 * DFF * DM * 2);
constexpr size_t WS_WIN = WS_WD1 + al((size_t)DM * DFF * 2);
constexpr size_t WS_WCO = WS_WIN + al((size_t)INC * DM * 2);
constexpr size_t WS_WAO = WS_WCO + al((size_t)DM * DCONV * 2);
constexpr size_t WS_WOUT = WS_WAO + al((size_t)DM * QW * 2);
constexpr size_t WS_WGU2 = WS_WOUT + al((size_t)DM * DM * 2);
constexpr size_t WS_WD2 = WS_WGU2 + al((size_t)2 * DFF * DM * 2);
constexpr size_t WS_WPG = WS_WD2 + al((size_t)DM * DFF * 2);
constexpr size_t WS_WPE = WS_WPG + al((size_t)DM * DM * 2);
constexpr size_t WS_XB = WS_WPE + al((size_t)DM * DPLE * 2);
constexpr size_t WS_PB = WS_XB + al((size_t)M * DM * 2);
constexpr size_t WS_ROPE = WS_PB + al((size_t)M * DPLE * 2);
constexpr size_t WS_SS = WS_ROPE + al((size_t)2 * 4160 * 8 * 4);
constexpr size_t SS_BYTES = al((size_t)M * 32 * 4);
constexpr size_t WS_R = WS_SS + 5 * SS_BYTES;
constexpr int UROWS = M + 30 * (NBP + NBS);
constexpr size_t R_U = 0, R_Q = R_U + (size_t)UROWS * DCONV * 2, R_K = R_Q + (size_t)M * QW * 2, R_V = R_K + (size_t)M * KVW * 2,
                 R_GA = R_V + (size_t)M * KVW * 2, R_GB = R_GA + (size_t)M * DM * 2, R_END = R_GB + (size_t)M * DM * 2;
static_assert(R_END >= (size_t)M * DFF * 2 && R_END >= (size_t)M * DM * 4, "region R");
constexpr size_t WS_SLAB = WS_R + al(R_END);
constexpr size_t WS_PROJ = WS_SLAB + (size_t)256 * 65536 * 2;
constexpr size_t WS_END = WS_PROJ + al((size_t)M * DM * 2);
constexpr int CW_FLAG = 8192;
constexpr int CW_BAR = 1024;

constexpr int RING_BYTES = 131072, LDSCTL_OFF = RING_BYTES, MISC_OFF = LDSCTL_OFF + 320, LDS_BYTES = 147456;
constexpr int NWAVES = 8;

typedef __bf16 bf16x2_t __attribute__((ext_vector_type(2)));
__device__ __forceinline__ unsigned cvt_pk_bf16(float lo, float hi) { f32x2 v = {lo, hi}; bf16x2_t b = __builtin_convertvector(v, bf16x2_t); return __builtin_bit_cast(unsigned, b); }
__device__ __forceinline__ float bf2f(unsigned h) { return __uint_as_float(h << 16); }
__device__ __forceinline__ int urow(int r) { return r < MP ? r + 30 * ((r >> 12) + 1) : r + 30 * (((r - MP) >> 6) + 3); }
__device__ __forceinline__ float fsigmoid(float x) { return __builtin_amdgcn_rcpf(1.f + __expf(-x)); }

namespace pg8 {
constexpr int BM = 256, BK = 64, HALF = 128, HTB = HALF * BK * 2, STAGE_BYTES = 8 * HTB, NXCD = 8, WGM = 8;
__host__ __device__ __forceinline__ int lds_byte(int r, int c) { const int st = (r >> 4) * 2 + (c >> 5), rr = r & 15, cc = c & 31, ob = rr * 64 + cc * 2; return st * 1024 + (ob ^ (((ob >> 9) & 1) << 5)); }
__host__ __device__ __forceinline__ void stage_rc(int b, int& R, int& C) { const int st = b / 1024, sb = b % 1024, swz = sb ^ (((sb >> 9) & 1) << 5); R = (st >> 1) * 16 + swz / 64; C = (st & 1) * 32 + (swz % 64) / 2; }
__host__ __device__ __forceinline__ int perm32(int rho) { const int n = rho >> 4, i = rho & 15; return 8 * (i >> 2) + 4 * n + (i & 3); }

struct Unit { int pm, pn, kt0, ntu, kind, slab, ui; };
struct Gemm { const bf16_t* A; const bf16_t* Bt; int M, N, K; };

struct StaticOrder {
    int nM, nN, nwg, G, c, ntK;
    __host__ __device__ void init(int M_, int N_, int K_, int G_, int c_) { nM = M_ / BM; nN = N_ / BM; nwg = nM * nN; G = G_; c = c_; ntK = K_ / BK; }
    __host__ __device__ __forceinline__ bool next(int i, Unit& u) const {
        const long L = (long)i * G + c; if (L >= nwg) return false;
        int wgid = (int)L; { const int q = nwg / NXCD, r = nwg % NXCD, xcd = wgid % NXCD, off = wgid / NXCD; wgid = (xcd < r ? xcd * (q + 1) : r * (q + 1) + (xcd - r) * q) + off; }
        const int nig = WGM * nN, gid = wgid / nig, fm = gid * WGM, gsz = (nM - fm) < WGM ? (nM - fm) : WGM;
        u.pm = fm + ((wgid % nig) % gsz); u.pn = (wgid % nig) / gsz; u.kt0 = 0; u.ntu = ntK; u.kind = 0; u.slab = 0; u.ui = i; return true;
    }
    __device__ __forceinline__ void a_ready(const Unit&) const {}
    __device__ __forceinline__ void done(const Unit&) const {}
};

struct InOrder : StaticOrder {
    __device__ __forceinline__ bool next(int i, Unit& u) const {
        if (!StaticOrder::next(i, u)) return false;
        const int pos = u.pn, a = pos >> 3, b = pos & 7;
        u.pn = pos < 24 ? (b < 4 ? 4 * a + b : 14 + 4 * a + (b - 4)) : (pos < 26 ? pos - 12 : pos);
        return true;
    }
};

struct StreamK {
    int P, v; long s, e;
    __device__ __forceinline__ void init(int K_, int G_, int bx) {
        P = K_ / 128; v = bx; if (G_ == 256) { const int x = bx & 7, j = bx >> 3; v = 16 * (j >> 1) + 2 * x + (j & 1); }
        const long tot = 272L * P; s = (long)v * tot / G_; e = (long)(v + 1) * tot / G_;
        if (G_ == 256) { const int d = v & 15; const long base = 17L * P * (v >> 4), r = 16L * P - 1;
            s = d ? base + (P + 1) + (long)(d - 1) * r / 15 : base; e = base + (P + 1) + (long)d * r / 15; } }
    __device__ __forceinline__ bool next(int i, Unit& u) const {
        const long t = s / P + i, lo = s > t * P ? s : t * P, hi = e < (t + 1) * P ? e : (t + 1) * P;
        if (lo >= hi) return false;
        const int a = (int)(t / 17), b = (int)(t % 17);
        if (b < 16) { u.pm = 4 * (b >> 1) + (a >> 2); u.pn = 4 * (b & 1) + (a & 3); } else { u.pm = 32 + (a >> 3); u.pn = a & 7; }
        u.kt0 = 2 * (int)(lo - t * P); u.ntu = 2 * (int)(hi - lo);
        u.kind = (hi - lo == P) ? 0 : (lo == t * P ? 2 : 1); u.slab = (u.kind == 1) ? v : v + 1; u.ui = i;
        return true;
    }
    __device__ __forceinline__ void a_ready(const Unit&) const {}
    __device__ __forceinline__ void done(const Unit&) const {}
};

struct SlackOrder {
    int first, n, ntK, c;
    __device__ __forceinline__ void init(int K_, int G_, int first_, int bx) { first = first_; n = G_ - first_; ntK = K_ / BK; c = bx - first_; }
    __device__ __forceinline__ bool next(int i, Unit& u) const {
        if (c < 0) return false; const int t = c + n * i; if (t >= 272) return false;
        u.pm = t >> 3; u.pn = t & 7; u.kt0 = 0; u.ntu = ntK; u.kind = 0; u.slab = 0; u.ui = i; return true;
    }
    __device__ __forceinline__ void a_ready(const Unit&) const {}
    __device__ __forceinline__ void done(const Unit&) const {}
};

template <class Epi, class Sched, bool ALIGN_EPI = false, bool SP2 = false, int MIDFIX = 0>
__device__ __forceinline__ void gemm_phase(LAS unsigned char* lds, int wid_in, const Gemm g, const Sched& S, const Epi& E, float* slabs = nullptr, unsigned* flags = nullptr) {
    int lane_ = __builtin_amdgcn_mbcnt_hi(~0u, __builtin_amdgcn_mbcnt_lo(~0u, 0u)); asm volatile("" : "+v"(lane_));
    const int wid = wid_in, lane = lane_, tid = wid * 64 + lane, wr = wid >> 2, wc = wid & 3, fr = lane & 15, fq = lane >> 4;
    const int K = g.K;
    unsigned voffA[2], voffB[2];
#pragma unroll
    for (int i = 0; i < 2; ++i) { int R, C; stage_rc(tid * 16 + i * 8192, R, C); const int Rb = Epi::PERM ? ((R & ~31) + perm32(R & 31)) : R;
        voffA[i] = (unsigned)(R * K + C) * 2u; voffB[i] = (unsigned)(Rb * K + C) * 2u; }
    const size_t kstep = (size_t)(BK * 2);
    const size_t hstep = (size_t)HALF * K * 2;
    const size_t tstep = 2 * hstep;
    const unsigned ldsw = (unsigned)wid * 1024u;
    const int aoff = lds_byte(wr * 64 + fr, fq * 8), boff = lds_byte(wc * 32 + fr, fq * 8);
#define PG8_SA(b, h) (((b) * 2 + (h)) * HTB)
#define PG8_SB(b, h) ((4 + (b) * 2 + (h)) * HTB)
#define PG8_STAGE(bufoff, gbase, voff) do { _Pragma("unroll") for (int _i = 0; _i < 2; ++_i) \
        __builtin_amdgcn_global_load_lds((const unsigned*)((const char*)(gbase) + (voff)[_i]), (LAS unsigned*)(lds + (bufoff) + ldsw + _i * 8192), 16, 0, 0); } while (0)
#define PG8_LDA(dst, b, h) do { _Pragma("unroll") for (int m = 0; m < 4; ++m) _Pragma("unroll") for (int k = 0; k < 2; ++k) dst[m][k] = *(const LAS bf16x8*)(lds + PG8_SA(b, h) + aoff + m * 2048 + k * 1024); } while (0)
#define PG8_LDB(dst, b, h) do { _Pragma("unroll") for (int n = 0; n < 2; ++n) _Pragma("unroll") for (int k = 0; k < 2; ++k) dst[n][k] = *(const LAS bf16x8*)(lds + PG8_SB(b, h) + boff + n * 2048 + k * 1024); } while (0)
#define PG8_MMA(ai, bj, At, Bt) do { __builtin_amdgcn_s_setprio(1); _Pragma("unroll") for (int m = 0; m < 4; ++m) _Pragma("unroll") for (int n = 0; n < 2; ++n) _Pragma("unroll") for (int k = 0; k < 2; ++k) \
        acc[ai][bj][m][n] = __builtin_amdgcn_mfma_f32_16x16x32_bf16(Bt[n][k], At[m][k], acc[ai][bj][m][n], 0, 0, 0); __builtin_amdgcn_s_setprio(0); } while (0)
#define PG8_WAIT_V(n) asm volatile("s_waitcnt vmcnt(" #n ")" ::: "memory")
#define PG8_WAIT_L(n) asm volatile("s_waitcnt lgkmcnt(" #n ")" ::: "memory")
#define PG8_BAR __builtin_amdgcn_s_barrier()
#define PG8_SCHED __builtin_amdgcn_sched_barrier(0)
    Unit cur, nxt; int ui = 0;
    if (!S.next(0, cur)) return;
    f32x4 acc[2][2][4][2];
#pragma unroll
    for (int a = 0; a < 2; ++a)
#pragma unroll
        for (int b = 0; b < 2; ++b)
#pragma unroll
            for (int m = 0; m < 4; ++m)
#pragma unroll
                for (int n = 0; n < 2; ++n) acc[a][b][m][n] = (f32x4){0.f, 0.f, 0.f, 0.f};
    bf16x8 At[4][2], B0[2][2], B1[2][2];
    const char* cA = (const char*)g.A + (size_t)cur.pm * tstep + (size_t)cur.kt0 * kstep; const char* cB = (const char*)g.Bt + (size_t)cur.pn * tstep + (size_t)cur.kt0 * kstep;
    S.a_ready(cur);
    if constexpr (SP2) {
        PG8_STAGE(PG8_SB(0, 0), cB, voffB); PG8_STAGE(PG8_SB(0, 1), cB + hstep, voffB); PG8_STAGE(PG8_SA(0, 0), cA, voffA); PG8_STAGE(PG8_SA(0, 1), cA + hstep, voffA);
        E.pre(lds, S, wid, lane);
        if (wr == 1) PG8_BAR;
        PG8_WAIT_V(2); PG8_BAR;
        PG8_STAGE(PG8_SB(1, 0), cB + kstep, voffB); PG8_STAGE(PG8_SA(1, 0), cA + kstep, voffA); PG8_STAGE(PG8_SB(1, 1), cB + hstep + kstep, voffB);
        PG8_WAIT_V(6); PG8_BAR;
    } else {
        PG8_STAGE(PG8_SB(0, 0), cB, voffB); PG8_STAGE(PG8_SA(0, 0), cA, voffA); PG8_STAGE(PG8_SB(0, 1), cB + hstep, voffB); PG8_STAGE(PG8_SA(0, 1), cA + hstep, voffA);
        if (wr == 1) PG8_BAR;
        PG8_WAIT_V(4); PG8_BAR;
        PG8_STAGE(PG8_SB(1, 0), cB + kstep, voffB); PG8_STAGE(PG8_SA(1, 0), cA + kstep, voffA); PG8_STAGE(PG8_SB(1, 1), cB + hstep + kstep, voffB);
        PG8_WAIT_V(6); PG8_BAR;
    }
    for (;;) {
        const bool has_next = S.next(ui + 1, nxt);
        const char* nA = has_next ? (const char*)g.A + (size_t)nxt.pm * tstep + (size_t)nxt.kt0 * kstep : cA; const char* nB = has_next ? (const char*)g.Bt + (size_t)nxt.pn * tstep + (size_t)nxt.kt0 * kstep : cB;
        const int nt = cur.ntu;
        asm volatile(".p2align 7\n\t.rept 16\n\ts_nop 0\n\t.endr");
        for (int t = 0; t < nt; t += 2) {
            if constexpr (MIDFIX != 0) { if (t > 0 && cur.kt0 + t == MIDFIX) {
                if (wr == 0) PG8_BAR;
                int lm = __builtin_amdgcn_mbcnt_hi(~0u, __builtin_amdgcn_mbcnt_lo(~0u, 0u)); asm volatile("" : "+v"(lm)); E.mid(acc, cur, wr, wc, lm & 15, lm >> 4);
                if (wr == 1) PG8_BAR; } }
            const bool last = (t == nt - 2);
            const char* a1 = cA + (size_t)(t + 1) * kstep;
            const char* a2 = last ? nA : cA + (size_t)(t + 2) * kstep; const char* b2 = last ? nB : cB + (size_t)(t + 2) * kstep;
            const char* a3 = a2 + kstep; const char* b3 = b2 + kstep;
            if (last && has_next) S.a_ready(nxt);
            if constexpr (SP2) {
            PG8_LDB(B0, 0, 0); PG8_LDB(B1, 0, 1); PG8_SCHED; PG8_LDA(At, 0, 0); PG8_STAGE(PG8_SA(1, 1), a1 + hstep, voffA);
            PG8_WAIT_V(8); PG8_WAIT_L(0); PG8_BAR; PG8_MMA(0, 0, At, B0); PG8_MMA(0, 1, At, B1); PG8_BAR; PG8_SCHED;
            PG8_LDA(At, 0, 1); PG8_STAGE(PG8_SB(0, 0), b2, voffB); PG8_STAGE(PG8_SB(0, 1), b2 + hstep, voffB); PG8_STAGE(PG8_SA(0, 0), a2, voffA);
            PG8_WAIT_V(8); PG8_WAIT_L(0); PG8_BAR; PG8_MMA(1, 0, At, B0); PG8_MMA(1, 1, At, B1); PG8_BAR; PG8_SCHED;
            PG8_LDB(B0, 1, 0); PG8_LDB(B1, 1, 1); PG8_SCHED; PG8_LDA(At, 1, 0); PG8_STAGE(PG8_SA(0, 1), a2 + hstep, voffA);
            PG8_WAIT_V(8); PG8_WAIT_L(0); PG8_BAR; PG8_MMA(0, 0, At, B0); PG8_MMA(0, 1, At, B1); PG8_BAR; PG8_SCHED;
            PG8_LDA(At, 1, 1); PG8_STAGE(PG8_SB(1, 0), b3, voffB); PG8_STAGE(PG8_SB(1, 1), b3 + hstep, voffB); PG8_STAGE(PG8_SA(1, 0), a3, voffA);
            PG8_WAIT_V(8); PG8_WAIT_L(0); PG8_BAR; PG8_MMA(1, 0, At, B0); PG8_MMA(1, 1, At, B1); PG8_BAR; PG8_SCHED;
            } else {
            PG8_LDB(B0, 0, 0); PG8_SCHED; PG8_LDA(At, 0, 0); PG8_STAGE(PG8_SA(1, 1), a1 + hstep, voffA);
            PG8_WAIT_L(8); PG8_BAR; PG8_WAIT_L(0); PG8_MMA(0, 0, At, B0); PG8_BAR; PG8_SCHED;
            PG8_LDB(B1, 0, 1); PG8_STAGE(PG8_SB(0, 0), b2, voffB);
            PG8_BAR; PG8_WAIT_L(0); PG8_MMA(0, 1, At, B1); PG8_BAR;
            PG8_LDA(At, 0, 1); PG8_STAGE(PG8_SA(0, 0), a2, voffA);
            PG8_BAR; PG8_WAIT_L(0); PG8_MMA(1, 0, At, B0); PG8_BAR; PG8_SCHED;
            PG8_STAGE(PG8_SB(0, 1), b2 + hstep, voffB);
            PG8_WAIT_V(6); PG8_BAR; PG8_MMA(1, 1, At, B1); PG8_BAR;
            PG8_LDB(B0, 1, 0); PG8_SCHED; PG8_LDA(At, 1, 0); PG8_STAGE(PG8_SA(0, 1), a2 + hstep, voffA);
            PG8_WAIT_L(8); PG8_BAR; PG8_WAIT_L(0); PG8_MMA(0, 0, At, B0); PG8_BAR; PG8_SCHED;
            PG8_LDB(B1, 1, 1); PG8_STAGE(PG8_SB(1, 0), b3, voffB);
            PG8_BAR; PG8_WAIT_L(0); PG8_MMA(0, 1, At, B1); PG8_BAR;
            PG8_LDA(At, 1, 1); PG8_STAGE(PG8_SA(1, 0), a3, voffA);
            PG8_BAR; PG8_WAIT_L(0); PG8_MMA(1, 0, At, B0); PG8_BAR; PG8_SCHED;
            PG8_STAGE(PG8_SB(1, 1), b3 + hstep, voffB);
            PG8_WAIT_V(6); PG8_BAR; PG8_MMA(1, 1, At, B1); PG8_BAR;
            }
        }
        if constexpr (ALIGN_EPI) { if (wr == 0) PG8_BAR; }
        int lane_e = __builtin_amdgcn_mbcnt_hi(~0u, __builtin_amdgcn_mbcnt_lo(~0u, 0u)); asm volatile("" : "+v"(lane_e));
        if constexpr (MIDFIX != 0) { if (cur.kt0 + nt <= MIDFIX) E.mid(acc, cur, wr, wc, lane_e & 15, lane_e >> 4); }
        if (cur.kind == 1) {
            const int tl = wid * 64 + lane_e;
            __amdgpu_buffer_rsrc_t rs_ = __builtin_amdgcn_make_buffer_rsrc((void*)(slabs + (size_t)cur.slab * 32768), 0, 131072, 0x00020000);
#pragma unroll
            for (int a = 0; a < 2; ++a)
#pragma unroll
                for (int b = 0; b < 2; ++b)
#pragma unroll
                    for (int m = 0; m < 4; ++m) { const f32x4 v0 = acc[a][b][m][0], v1 = acc[a][b][m][1];
                        u32x4 w; w.x = cvt_pk_bf16(v0[0], v0[1]); w.y = cvt_pk_bf16(v0[2], v0[3]); w.z = cvt_pk_bf16(v1[0], v1[1]); w.w = cvt_pk_bf16(v1[2], v1[3]);
                        __builtin_amdgcn_raw_buffer_store_b128(w, rs_, (tl + ((a * 2 + b) * 4 + m) * 512) * 16, 0, 16); }
            asm volatile("s_waitcnt vmcnt(0)" ::: "memory"); __builtin_amdgcn_s_barrier(); asm volatile("" ::: "memory");
            if (wid == 0 && lane_e == 0) __hip_atomic_store(flags + cur.slab, 1u, __ATOMIC_RELAXED, __HIP_MEMORY_SCOPE_AGENT);
        } else {
            if (cur.kind == 2) {
                if (wid == 0) { unsigned sp_ = 0; while ((unsigned)__builtin_amdgcn_readfirstlane(__hip_atomic_load(flags + cur.slab, __ATOMIC_RELAXED, __HIP_MEMORY_SCOPE_AGENT)) == 0u) { __builtin_amdgcn_s_sleep(2); if (++sp_ > (1u << 22)) break; }
                    __builtin_amdgcn_fence(__ATOMIC_ACQUIRE, "agent"); asm volatile("s_waitcnt vmcnt(0)" ::: "memory"); }
                asm volatile("" ::: "memory"); __builtin_amdgcn_s_barrier(); asm volatile("" ::: "memory");
            }
            { const int fr_ = lane_e & 15, fq_ = lane_e >> 4, tl = wid * 64 + lane_e;
              const f32x4* part = (cur.kind == 2) ? (const f32x4*)((const u32x4*)(slabs + (size_t)cur.slab * 32768) + tl) : nullptr;
              if constexpr (Epi::HAS_SIDE) {
                  float sv[32]; typename Epi::SideItem st; int sh = 0; const bool hs = E.side_load(cur, wid, lane_e, st, sh, sv);
                  asm volatile("" ::: "memory");
                  if (part) E.template run<true>(acc, cur, wr, wc, fr_, fq_, part); else E.template run<false>(acc, cur, wr, wc, fr_, fq_, part);
                  asm volatile("" ::: "memory");
                  if (hs) E.side_store(st, sh, lane_e, sv);
              } else {
                  if (part) E.template run<true>(acc, cur, wr, wc, fr_, fq_, part); else E.template run<false>(acc, cur, wr, wc, fr_, fq_, part);
              } }
        }
        S.done(cur);
        if (!has_next) break;
#pragma unroll
        for (int a = 0; a < 2; ++a)
#pragma unroll
            for (int b = 0; b < 2; ++b)
#pragma unroll
                for (int m = 0; m < 4; ++m)
#pragma unroll
                    for (int n = 0; n < 2; ++n) acc[a][b][m][n] = (f32x4){0.f, 0.f, 0.f, 0.f};
        cur = nxt; cA = nA; cB = nB; ++ui;
        if constexpr (ALIGN_EPI) { if (wr == 1) PG8_BAR; }
    }
    PG8_WAIT_V(0);
    if constexpr (!ALIGN_EPI) { if (wr == 0) PG8_BAR; }
    PG8_BAR;
#undef PG8_SA
#undef PG8_SB
#undef PG8_STAGE
#undef PG8_LDA
#undef PG8_LDB
#undef PG8_MMA
#undef PG8_WAIT_V
#undef PG8_WAIT_L
#undef PG8_BAR
#undef PG8_SCHED
}
}
using pg8::Unit;

__device__ __forceinline__ int swap23(int d) { return (d & 3) | (((d >> 3) & 1) << 2) | (((d >> 2) & 1) << 3); }
template <int MAP> __device__ __forceinline__ int dst_row(int n) {
    if (MAP == 0) return n;
    if (MAP == 1) { if (n < DFF) return 256 * (n >> 7) + (n & 127); const int q = n - DFF; return 256 * (q >> 7) + 128 + (q & 127); }
    if (n < 1024) return 256 * (n >> 7) + (n & 127);
    if (n < 2048) { const int q = n - 1024; return 256 * (q >> 7) + 128 + (q & 127); }
    if (n < 3328) { const int d = n & 63; return d < 16 ? (n & ~63) + swap23(d) : n; }
    return n;
}
struct TItem { const float* W; bf16_t* WT; const float* gain; int K, N, map, item, ldk, koff; };
__device__ __forceinline__ void titem_load(const TItem& t, int lane, float (&v)[64]) {
    const int nblk = t.N / 64, kb = t.item / nblk, nb = t.item % nblk;
    const float* src = t.W + (size_t)(64 * kb) * t.N + 64 * nb + lane;
#pragma unroll
    for (int i = 0; i < 64; ++i) v[i] = __builtin_nontemporal_load(src + (size_t)i * t.N);
}
__device__ __forceinline__ void titem_store(const TItem& t, int lane, float (&v)[64], LAS unsigned char* scr) {
    const int nblk = t.N / 64, kb = t.item / nblk, nb = t.item % nblk, k0 = 64 * kb, n0 = 64 * nb;
    if (t.gain) {
#pragma unroll
        for (int i = 0; i < 64; ++i) v[i] *= t.gain[k0 + i];
    }
#pragma unroll
    for (int c = 0; c < 8; ++c) {
        u32x4 o; o.x = cvt_pk_bf16(v[8 * c], v[8 * c + 1]); o.y = cvt_pk_bf16(v[8 * c + 2], v[8 * c + 3]); o.z = cvt_pk_bf16(v[8 * c + 4], v[8 * c + 5]); o.w = cvt_pk_bf16(v[8 * c + 6], v[8 * c + 7]);
        *(LAS u32x4*)(scr + lane * 144 + c * 16) = o;
    }
    asm volatile("s_waitcnt lgkmcnt(0)" ::: "memory");
#pragma unroll
    for (int j = 0; j < 8; ++j) {
        const int col = (lane >> 3) + 8 * j, c = lane & 7, n = n0 + col;
        const u32x4 o = *(const LAS u32x4*)(scr + col * 144 + c * 16);
        const int r = t.map == 0 ? dst_row<0>(n) : (t.map == 1 ? dst_row<1>(n) : dst_row<2>(n));
        *(u32x4*)(t.WT + (size_t)r * t.ldk + t.koff + k0 + 8 * c) = o;
    }
    asm volatile("s_waitcnt lgkmcnt(0)" ::: "memory");
}

__device__ __forceinline__ void titem_load_half(const TItem& t, int half, int lane, float (&v)[32]) {
    const int nblk = t.N / 64, kb = t.item / nblk, nb = t.item % nblk;
    const float* src = t.W + (size_t)(64 * kb + 32 * half) * t.N + 64 * nb + lane;
#pragma unroll
    for (int i = 0; i < 32; ++i) v[i] = __builtin_nontemporal_load(src + (size_t)i * t.N);
}
__device__ __forceinline__ void titem_store_direct(const TItem& t, int half, int lane, float (&v)[32]) {
    const int nblk = t.N / 64, kb = t.item / nblk, nb = t.item % nblk, k0 = 64 * kb + 32 * half, n = 64 * nb + lane;
    if (t.gain) {
#pragma unroll
        for (int i = 0; i < 32; ++i) v[i] *= t.gain[k0 + i];
    }
    const int r = t.map == 0 ? dst_row<0>(n) : (t.map == 1 ? dst_row<1>(n) : dst_row<2>(n));
    bf16_t* dst = t.WT + (size_t)r * t.ldk + t.koff + k0;
#pragma unroll
    for (int c = 0; c < 4; ++c) {
        u32x4 o; o.x = cvt_pk_bf16(v[8 * c], v[8 * c + 1]); o.y = cvt_pk_bf16(v[8 * c + 2], v[8 * c + 3]); o.z = cvt_pk_bf16(v[8 * c + 4], v[8 * c + 5]); o.w = cvt_pk_bf16(v[8 * c + 6], v[8 * c + 7]);
        *(u32x4*)(dst + 8 * c) = o;
    }
}
struct SideWork {
    const float *w_d1, *w_co, *w_ao, *w_out; unsigned char* ws; int n_items, G, bx;
    __device__ __forceinline__ bool pick(int ui, int wid, TItem& t, int& half) const {
        const int hq = (ui * G + bx) * NWAVES + wid; if (hq >= 2 * n_items) return false; const int q = hq >> 1; half = hq & 1;
        constexpr int I_D = (DFF / 64) * (DM / 64), I_C = (DCONV / 64) * (DM / 64);
        int r = q;
        if (r < I_D) { t = TItem{w_d1, (bf16_t*)(ws + WS_WD1), nullptr, DFF, DM, 0, r, DFF, 0}; return true; } r -= I_D;
        if (r < I_C) { t = TItem{w_co, (bf16_t*)(ws + WS_WCO), nullptr, DCONV, DM, 0, r, DM, 0}; return true; } r -= I_C;
        if (r < I_C) { t = TItem{w_ao, (bf16_t*)(ws + WS_WCO), nullptr, QW, DM, 0, r, DM, DCONV}; return true; } r -= I_C;
        t = TItem{w_out, (bf16_t*)(ws + WS_WOUT), nullptr, DM, DM, 0, r, DM, 0}; return true;
    }
};
constexpr int SIDE_ITEMS = (DFF / 64) * (DM / 64) + 2 * (DCONV / 64) * (DM / 64) + (DM / 64) * (DM / 64);
static_assert(2 * SIDE_ITEMS <= 5 * 256 * NWAVES, "side items must fit the slots every workgroup has");

constexpr int RST_OFF = 131072 + 1024, RST_MAXU = 7;
template <class Sched> __device__ __forceinline__ void build_rs_table(LAS unsigned char* lds, const Sched& S, const float* part, int wave, int lane) {
    LAS float* T = (LAS float*)(lds + RST_OFF);
    const int t = wave * 64 + lane, row = t >> 1, half = t & 1;
    Unit u; float sv[RST_MAXU];
#pragma unroll
    for (int i = 0; i < RST_MAXU; ++i) { sv[i] = 0.f;
        if (S.next(i, u)) { const f32x4* p = (const f32x4*)(part + (size_t)(u.pm * 256 + row) * 32 + half * 16);
            const f32x4 a = p[0], b = p[1], c = p[2], d = p[3]; const f32x4 q = (a + b) + (c + d); sv[i] = (q[0] + q[1]) + (q[2] + q[3]); } }
#pragma unroll
    for (int i = 0; i < RST_MAXU; ++i) { float sq = sv[i]; sq += __shfl_xor(sq, 1); if (half == 0) T[i * 256 + row] = rsqrtf(sq * (1.0f / DM) + EPS); }
    __syncthreads();
}
__device__ __forceinline__ void load_rs(const LAS float* lds_tab_unit, int rloc, float (&rs)[2][4]) {
#pragma unroll
    for (int ai = 0; ai < 2; ++ai)
#pragma unroll
        for (int m = 0; m < 4; ++m) rs[ai][m] = lds_tab_unit[rloc + ai * 128 + m * 16];
}

__device__ __forceinline__ f32x4 slab_half(const u32x4* sp, int piece, int n) {
    const u32x4 w = sp[piece * 512]; const unsigned lo = n ? w.z : w.x, hi = n ? w.w : w.y;
    return (f32x4){bf2f(lo & 0xffffu), __uint_as_float(lo & 0xffff0000u), bf2f(hi & 0xffffu), __uint_as_float(hi & 0xffff0000u)};
}
#define ACCP(ai, bj, m, n) (HP ? acc[ai][bj][m][n] + slab_half((const u32x4*)slabp, (((ai) * 2 + (bj)) * 4 + (m)), (n)) : acc[ai][bj][m][n])

struct EpiSwiGLU {
    static constexpr bool HAS_SIDE = true;
    typedef TItem SideItem;
    SideWork sw;
    __device__ __forceinline__ bool side_load(const Unit& u, int wid, int lane, TItem& t, int& half, float (&v)[32]) const { if (!sw.pick(u.ui, wid, t, half)) return false; titem_load_half(t, half, lane, v); return true; }
    __device__ __forceinline__ void side_store(const TItem& t, int half, int lane, float (&v)[32]) const { titem_store_direct(t, half, lane, v); }
    const float* ss_src;
    template <class Sched> __device__ __forceinline__ void pre(LAS unsigned char* l, const Sched& S, int wave, int lane) const { build_rs_table(l, S, ss_src, wave, lane); }
    static constexpr bool PERM = true, AFTER_DRAIN = false;
    bf16_t* H; const LAS float* part;
    template <bool HP> __device__ __forceinline__ void run(const f32x4 (&acc)[2][2][4][2], const Unit& u, int wr, int wc, int fr, int fq, const f32x4* slabp) const {
        const int row0 = u.pm * 256 + wr * 64 + fr, col0 = u.pn * 128 + wc * 32 + 8 * fq;
        float rs[2][4]; load_rs(part + u.ui * 256, wr * 64 + fr, rs);
#pragma unroll
        for (int ai = 0; ai < 2; ++ai)
#pragma unroll
            for (int m = 0; m < 4; ++m) {
                const float r = rs[ai][m], r2 = -r * 1.4426950408889634f, rr = r * r; float h[8];
#pragma unroll
                for (int n = 0; n < 2; ++n)
#pragma unroll
                    for (int j = 0; j < 4; ++j) { const float ag = acc[ai][0][m][n][j], au = acc[ai][1][m][n][j];
                        h[n * 4 + j] = (ag * au) * rr * __builtin_amdgcn_rcpf(1.f + __builtin_amdgcn_exp2f(ag * r2)); }
                u32x4 w; w.x = cvt_pk_bf16(h[0], h[1]); w.y = cvt_pk_bf16(h[2], h[3]); w.z = cvt_pk_bf16(h[4], h[5]); w.w = cvt_pk_bf16(h[6], h[7]);
                *(u32x4*)(H + (size_t)(row0 + ai * 128 + m * 16) * DFF + col0) = w;
            }
    }
};

struct EpiResid {
    static constexpr bool HAS_SIDE = false;
    template <class Sched> __device__ __forceinline__ void pre(LAS unsigned char*, const Sched&, int, int) const {}
    static constexpr bool PERM = true, AFTER_DRAIN = false;
    bf16_t* xb; float* part_out; float scale;
    template <bool HP> __device__ __forceinline__ void run(const f32x4 (&acc)[2][2][4][2], const Unit& u, int wr, int wc, int fr, int fq, const f32x4* slabp) const {
        const int row0 = u.pm * 256 + wr * 64 + fr, col0 = u.pn * 256 + wc * 32 + 8 * fq;
        constexpr int MB = HP ? 2 : 4;
#pragma unroll
        for (int ai = 0; ai < 2; ++ai)
#pragma unroll
          for (int mh = 0; mh < 4 / MB; ++mh) {
            u32x4 xi[MB][2];
#pragma unroll
            for (int ml = 0; ml < MB; ++ml)
#pragma unroll
                for (int bj = 0; bj < 2; ++bj) xi[ml][bj] = *(const u32x4*)(xb + (size_t)(row0 + ai * 128 + (mh * MB + ml) * 16) * DM + col0 + bj * 128);
#pragma unroll
            for (int ml = 0; ml < MB; ++ml) {
                const int m = mh * MB + ml, row = row0 + ai * 128 + m * 16; float ss = 0.f;
#pragma unroll
                for (int bj = 0; bj < 2; ++bj) {
                    const u32x4 xw = xi[ml][bj]; const f32x4 a0 = ACCP(ai, bj, m, 0), a1 = ACCP(ai, bj, m, 1); float o[8];
#pragma unroll
                    for (int q = 0; q < 4; ++q) {
                        o[2 * q] = bf2f(xw[q] & 0xffffu) + (q < 2 ? a0 : a1)[(q & 1) * 2] * scale;
                        o[2 * q + 1] = __uint_as_float(xw[q] & 0xffff0000u) + (q < 2 ? a0 : a1)[(q & 1) * 2 + 1] * scale;
                        ss += o[2 * q] * o[2 * q] + o[2 * q + 1] * o[2 * q + 1];
                    }
                    u32x4 w; w.x = cvt_pk_bf16(o[0], o[1]); w.y = cvt_pk_bf16(o[2], o[3]); w.z = cvt_pk_bf16(o[4], o[5]); w.w = cvt_pk_bf16(o[6], o[7]);
                    *(u32x4*)(xb + (size_t)row * DM + col0 + bj * 128) = w;
                }
                ss += __shfl_xor(ss, 16); ss += __shfl_xor(ss, 32);
                if (fq == 0) part_out[(size_t)row * 32 + u.pn * 4 + wc] = ss;
            }
            asm volatile("" ::: "memory");
          }
    }
};

struct EpiBf16 {
    static constexpr bool HAS_SIDE = false;
    template <class Sched> __device__ __forceinline__ void pre(LAS unsigned char*, const Sched&, int, int) const {}
    static constexpr bool PERM = true, AFTER_DRAIN = false;
    bf16_t* C;
    template <bool HP> __device__ __forceinline__ void run(const f32x4 (&acc)[2][2][4][2], const Unit& u, int wr, int wc, int fr, int fq, const f32x4* slabp) const {
        const int row0 = u.pm * 256 + wr * 64 + fr, col0 = u.pn * 256 + wc * 32 + 8 * fq;
#pragma unroll
        for (int ai = 0; ai < 2; ++ai)
#pragma unroll
            for (int m = 0; m < 4; ++m) { bf16_t* rowp = C + (size_t)(row0 + ai * 128 + m * 16) * DM + col0;
#pragma unroll
                for (int bj = 0; bj < 2; ++bj) { const f32x4 v0 = acc[ai][bj][m][0], v1 = acc[ai][bj][m][1];
                    u32x4 w; w.x = cvt_pk_bf16(v0[0], v0[1]); w.y = cvt_pk_bf16(v0[2], v0[3]); w.z = cvt_pk_bf16(v1[0], v1[1]); w.w = cvt_pk_bf16(v1[2], v1[3]);
                    *(u32x4*)(rowp + bj * 128) = w; } }
    }
};

struct EpiPle {
    static constexpr bool HAS_SIDE = false;
    const float* ss_src;
    template <class Sched> __device__ __forceinline__ void pre(LAS unsigned char* l, const Sched& S, int wave, int lane) const { build_rs_table(l, S, ss_src, wave, lane); }
    static constexpr bool PERM = true, AFTER_DRAIN = false;
    bf16_t* X; const bf16_t* xb; const bf16_t* proj; const LAS float* part_in; float* part_out;
    template <bool HP> __device__ __forceinline__ void run(const f32x4 (&acc)[2][2][4][2], const Unit& u, int wr, int wc, int fr, int fq, const f32x4* slabp) const {
        const int row0 = u.pm * 256 + wr * 64 + fr, col0 = u.pn * 256 + wc * 32 + 8 * fq;
        const LAS float* rst = part_in + u.ui * 256 + wr * 64 + fr;
#pragma unroll
        for (int ai = 0; ai < 2; ++ai)
#pragma unroll
          for (int mh = 0; mh < 2; ++mh) {
            u32x4 xi[2][2], pj[2][2];
#pragma unroll
            for (int ml = 0; ml < 2; ++ml)
#pragma unroll
                for (int bj = 0; bj < 2; ++bj) { const size_t off = (size_t)(row0 + ai * 128 + (mh * 2 + ml) * 16) * DM + col0 + bj * 128; xi[ml][bj] = *(const u32x4*)(xb + off); pj[ml][bj] = *(const u32x4*)(proj + off); }
#pragma unroll
            for (int ml = 0; ml < 2; ++ml) {
                const int m = mh * 2 + ml, row = row0 + ai * 128 + m * 16; const float r = rst[ai * 128 + m * 16]; float ss = 0.f;
#pragma unroll
                for (int bj = 0; bj < 2; ++bj) {
                    const u32x4 xw = xi[ml][bj], pw = pj[ml][bj]; const f32x4 a0 = ACCP(ai, bj, m, 0), a1 = ACCP(ai, bj, m, 1); float o[8];
#pragma unroll
                    for (int q = 0; q < 4; ++q) {
                        o[2 * q] = bf2f(xw[q] & 0xffffu) + fsigmoid((q < 2 ? a0 : a1)[(q & 1) * 2] * r) * bf2f(pw[q] & 0xffffu);
                        o[2 * q + 1] = __uint_as_float(xw[q] & 0xffff0000u) + fsigmoid((q < 2 ? a0 : a1)[(q & 1) * 2 + 1] * r) * __uint_as_float(pw[q] & 0xffff0000u);
                        ss += o[2 * q] * o[2 * q] + o[2 * q + 1] * o[2 * q + 1];
                    }
                    u32x4 w; w.x = cvt_pk_bf16(o[0], o[1]); w.y = cvt_pk_bf16(o[2], o[3]); w.z = cvt_pk_bf16(o[4], o[5]); w.w = cvt_pk_bf16(o[6], o[7]);
                    *(u32x4*)(X + (size_t)row * DM + col0 + bj * 128) = w;
                }
                ss += __shfl_xor(ss, 16); ss += __shfl_xor(ss, 32);
                if (fq == 0) part_out[(size_t)row * 32 + u.pn * 4 + wc] = ss;
            }
            asm volatile("" ::: "memory");
          }
    }
};

struct EpiMerge {
    static constexpr bool HAS_SIDE = false;
    template <class Sched> __device__ __forceinline__ void pre(LAS unsigned char*, const Sched&, int, int) const {}
    static constexpr bool PERM = true, AFTER_DRAIN = false;
    const bf16_t* GA; const bf16_t* GB; bf16_t* MG;
    __device__ __forceinline__ void mid(f32x4 (&acc)[2][2][4][2], const Unit& u, int wr, int wc, int fr, int fq) const {
        const int row0 = u.pm * 256 + wr * 64 + fr, col0 = u.pn * 256 + wc * 32 + 8 * fq;
#pragma unroll
        for (int ai = 0; ai < 2; ++ai) {
#pragma unroll
            for (int m = 0; m < 4; ++m) {
#pragma unroll
                for (int bj = 0; bj < 2; ++bj) {
                    const size_t off = (size_t)(row0 + ai * 128 + m * 16) * DM + col0 + bj * 128;
                    const u32x4 aw = *(const u32x4*)(GA + off), bw = *(const u32x4*)(GB + off);
#pragma unroll
                    for (int q = 0; q < 4; ++q) {
                        const float a0 = bf2f(aw[q] & 0xffffu), a1 = __uint_as_float(aw[q] & 0xffff0000u);
                        const float b0 = fmaxf(bf2f(bw[q] & 0xffffu), 1e-30f), b1 = fmaxf(__uint_as_float(bw[q] & 0xffff0000u), 1e-30f);
                        acc[ai][bj][m][q >> 1][(q & 1) * 2] *= a0 * __builtin_amdgcn_rcpf(b0);
                        acc[ai][bj][m][q >> 1][(q & 1) * 2 + 1] *= a1 * __builtin_amdgcn_rcpf(b1);
                    }
                }
            }
            asm volatile("" ::: "memory");
        }
    }
    template <bool HP> __device__ __forceinline__ void run(const f32x4 (&acc)[2][2][4][2], const Unit& u, int wr, int wc, int fr, int fq, const f32x4* slabp) const {
        const int row0 = u.pm * 256 + wr * 64 + fr, col0 = u.pn * 256 + wc * 32 + 8 * fq;
#pragma unroll
        for (int ai = 0; ai < 2; ++ai) {
#pragma unroll
            for (int m = 0; m < 4; ++m) {
#pragma unroll
                for (int bj = 0; bj < 2; ++bj) {
                    const size_t off = (size_t)(row0 + ai * 128 + m * 16) * DM + col0 + bj * 128;
                    const u32x4 bw = *(const u32x4*)(GB + off);
                    const f32x4 av0 = ACCP(ai, bj, m, 0), av1 = ACCP(ai, bj, m, 1); float o[8];
#pragma unroll
                    for (int q = 0; q < 4; ++q) {
                        const float b0 = fmaxf(bf2f(bw[q] & 0xffffu), 1e-30f), b1 = fmaxf(__uint_as_float(bw[q] & 0xffff0000u), 1e-30f);
                        o[2 * q] = b0 * (q < 2 ? av0 : av1)[(q & 1) * 2]; o[2 * q + 1] = b1 * (q < 2 ? av0 : av1)[(q & 1) * 2 + 1];
                    }
                    u32x4 w; w.x = cvt_pk_bf16(o[0], o[1]); w.y = cvt_pk_bf16(o[2], o[3]); w.z = cvt_pk_bf16(o[4], o[5]); w.w = cvt_pk_bf16(o[6], o[7]);
                    *(u32x4*)(MG + off) = w;
                }
                if (HP && (m & 1)) asm volatile("" ::: "memory");
            }
            asm volatile("" ::: "memory");
        }
    }
};

__device__ constexpr float RV_HI[8] = {1.591549367e-01f, 3.086376376e-02f, 5.985185504e-03f, 1.160663669e-03f, 2.250790858e-04f, 4.364795313e-05f, 8.464330676e-06f, 1.641426252e-06f};
__device__ constexpr float RV_LO[8] = {6.420638243e-09f, -3.597993847e-10f, 2.087540557e-10f, -2.775752544e-11f, -6.755001072e-12f, -3.416928741e-13f, 1.318804142e-13f, 1.098673646e-14f};
struct EpiIn {
    static constexpr bool HAS_SIDE = false;
    const float* ss_src;
    template <class Sched> __device__ __forceinline__ void pre(LAS unsigned char* l, const Sched& S, int wave, int lane) const { build_rs_table(l, S, ss_src, wave, lane); }
    static constexpr bool PERM = true, AFTER_DRAIN = false;
    const LAS float* part; bf16_t *U, *Q, *Kb, *Vb, *GA, *GB; const float *cosT, *sinT; float* out;
    template <bool HP> __device__ __forceinline__ void run(const f32x4 (&acc)[2][2][4][2], const Unit& u, int wr, int wc, int fr, int fq, const f32x4* slabp) const {
        const int row0 = u.pm * 256 + wr * 64 + fr, pn = u.pn;
        float rs[2][4]; load_rs(part + u.ui * 256, wr * 64 + fr, rs);
        const bool samp = u.pm >= 32;
        if (pn < 8) {
            const int ch0 = pn * 128 + wc * 32 + 8 * fq;
#pragma unroll
            for (int ai = 0; ai < 2; ++ai)
#pragma unroll
                for (int m = 0; m < 4; ++m) {
                    const int row = row0 + ai * 128 + m * 16; const float r = rs[ai][m]; float h[8];
#pragma unroll
                    for (int n = 0; n < 2; ++n)
#pragma unroll
                        for (int j = 0; j < 4; ++j) h[n * 4 + j] = (acc[ai][0][m][n][j] * r) * fsigmoid(acc[ai][1][m][n][j] * r);
                    u32x4 w; w.x = cvt_pk_bf16(h[0], h[1]); w.y = cvt_pk_bf16(h[2], h[3]); w.z = cvt_pk_bf16(h[4], h[5]); w.w = cvt_pk_bf16(h[6], h[7]);
                    *(u32x4*)(U + (size_t)urow(row) * DCONV + ch0) = w;
                    float* dst = nullptr;
                    if (!samp) { const int t = row & (SEQ - 1), b = row >> 12; if (t >= SEQ - 30) dst = out + OFF_CP + (size_t)(b * 30 + t - (SEQ - 30)) * DCONV + ch0; }
                    else { const int sr = row - MP, t = sr & 63, b = sr >> 6; if (t >= DSEQ - 30) dst = out + OFF_CS + (size_t)(b * 30 + t - (DSEQ - 30)) * DCONV + ch0; }
                    if (dst) { *(f32x4*)dst = (f32x4){h[0], h[1], h[2], h[3]}; *(f32x4*)(dst + 4) = (f32x4){h[4], h[5], h[6], h[7]}; }
                }
        } else if (pn < 13) {
            const bool isq = pn < 12;
            bf16_t* O = isq ? Q : Kb; const int ld = isq ? QW : KVW; const int tcol = isq ? (pn - 8) * 256 : 0;
            const bool rot = ((wc & 1) == 0) && (fq < 2);
            const float qs = isq ? 0.125f : 1.0f;
#pragma unroll
            for (int ai = 0; ai < 2; ++ai)
#pragma unroll
                for (int m = 0; m < 4; ++m) {
                    const int row = row0 + ai * 128 + m * 16; const float r = rs[ai][m] * qs;
                    int pidx, t, b; if (!samp) { t = row & (SEQ - 1); b = row >> 12; pidx = t; } else { const int sr = row - MP; t = sr & 63; b = sr >> 6; pidx = SEQ + t; }
                    float* kdst = nullptr;
                    if (!isq) { if (!samp) { if (t >= SEQ - WIN) kdst = out + OFF_KP + (size_t)(b * WIN + t - (SEQ - WIN)) * KVW; } else kdst = out + OFF_KS + (size_t)(b * WIN + 64 + t) * KVW; }
                    f32x4 cs = (f32x4){1.f, 1.f, 1.f, 1.f}, sn = (f32x4){0.f, 0.f, 0.f, 0.f};
                    if (rot) {
                        const float pf = (float)(pidx < SEQ ? pidx : PAST + (pidx - SEQ));
#pragma unroll
                        for (int j = 0; j < 4; ++j) {
                            const float ch = fq ? RV_HI[4 + j] : RV_HI[j], cl = fq ? RV_LO[4 + j] : RV_LO[j];
                            const float p = pf * ch, e = __builtin_fmaf(pf, ch, -p) + pf * cl;
                            const float rev = (p - __builtin_floorf(p)) + e;
                            cs[j] = __builtin_amdgcn_cosf(rev); sn[j] = __builtin_amdgcn_sinf(rev);
                        }
                    }
#pragma unroll
                    for (int bj = 0; bj < 2; ++bj) {
                        const f32x4 v0 = acc[ai][bj][m][0] * r, v1 = acc[ai][bj][m][1] * r;
                        const int cbase = tcol + bj * 128 + wc * 32;
                        if (rot) {
                            const f32x4 o1 = v0 * cs - v1 * sn, o2 = v1 * cs + v0 * sn;
                            u32x2 w1, w2; w1.x = cvt_pk_bf16(o1[0], o1[1]); w1.y = cvt_pk_bf16(o1[2], o1[3]); w2.x = cvt_pk_bf16(o2[0], o2[1]); w2.y = cvt_pk_bf16(o2[2], o2[3]);
                            *(u32x2*)(O + (size_t)row * ld + cbase + 4 * fq) = w1; *(u32x2*)(O + (size_t)row * ld + cbase + 8 + 4 * fq) = w2;
                            if (kdst) { *(f32x4*)(kdst + cbase + 4 * fq) = o1; *(f32x4*)(kdst + cbase + 8 + 4 * fq) = o2; }
                        } else {
                            u32x4 w; w.x = cvt_pk_bf16(v0[0], v0[1]); w.y = cvt_pk_bf16(v0[2], v0[3]); w.z = cvt_pk_bf16(v1[0], v1[1]); w.w = cvt_pk_bf16(v1[2], v1[3]);
                            *(u32x4*)(O + (size_t)row * ld + cbase + 8 * fq) = w;
                            if (kdst) { *(f32x4*)(kdst + cbase + 8 * fq) = v0; *(f32x4*)(kdst + cbase + 8 * fq + 4) = v1; }
                        }
                    }
                }
        } else if (pn == 13) {
#pragma unroll
            for (int ai = 0; ai < 2; ++ai)
#pragma unroll
                for (int m = 0; m < 4; ++m) {
                    const int row = row0 + ai * 128 + m * 16; const float r = rs[ai][m];
                    float* vdst = nullptr;
                    if (!samp) { const int t = row & (SEQ - 1), b = row >> 12; if (t >= SEQ - WIN) vdst = out + OFF_VP + (size_t)(b * WIN + t - (SEQ - WIN)) * KVW; }
                    else { const int sr = row - MP, t = sr & 63, b = sr >> 6; vdst = out + OFF_VS + (size_t)(b * WIN + 64 + t) * KVW; }
#pragma unroll
                    for (int bj = 0; bj < 2; ++bj) {
                        const f32x4 v0 = acc[ai][bj][m][0] * r, v1 = acc[ai][bj][m][1] * r; const int c = bj * 128 + wc * 32 + 8 * fq;
                        u32x4 w; w.x = cvt_pk_bf16(v0[0], v0[1]); w.y = cvt_pk_bf16(v0[2], v0[3]); w.z = cvt_pk_bf16(v1[0], v1[1]); w.w = cvt_pk_bf16(v1[2], v1[3]);
                        *(u32x4*)(Vb + (size_t)row * KVW + c) = w;
                        if (vdst) { *(f32x4*)(vdst + c) = v0; *(f32x4*)(vdst + c + 4) = v1; }
                    }
                }
        } else {
            bf16_t* O = pn < 22 ? GA : GB; const int tcol = (pn < 22 ? pn - 14 : pn - 22) * 256;
#pragma unroll
            for (int ai = 0; ai < 2; ++ai)
#pragma unroll
                for (int m = 0; m < 4; ++m) {
                    const int row = row0 + ai * 128 + m * 16; const float r = rs[ai][m];
#pragma unroll
                    for (int bj = 0; bj < 2; ++bj) {
                        float h[8];
#pragma unroll
                        for (int n = 0; n < 2; ++n)
#pragma unroll
                            for (int j = 0; j < 4; ++j) h[n * 4 + j] = fsigmoid(acc[ai][bj][m][n][j] * r);
                        u32x4 w; w.x = cvt_pk_bf16(h[0], h[1]); w.y = cvt_pk_bf16(h[2], h[3]); w.z = cvt_pk_bf16(h[4], h[5]); w.w = cvt_pk_bf16(h[6], h[7]);
                        *(u32x4*)(O + (size_t)row * DM + tcol + bj * 128 + wc * 32 + 8 * fq) = w;
                    }
                }
        }
    }
};

#define XB_TMO      128
#define XB_XCNT(j)  (256  + 64 * (j))
#define XB_XSUB(j)  (1280 + 64 * (j))
#define XB_XGEN(j)  (2304 + 64 * (j))
#define XB_TOP      3328
#define XB_TOPGEN   3392
#define XCD_BAR_WORDS 3456
#define XB_SPIN_CAP (1u << 18)
__device__ __forceinline__ unsigned xb_ld(unsigned* p)              { return __hip_atomic_load(p, __ATOMIC_RELAXED, __HIP_MEMORY_SCOPE_AGENT); }
__device__ __forceinline__ unsigned xb_add(unsigned* p, unsigned v) { return __hip_atomic_fetch_add(p, v, __ATOMIC_RELAXED, __HIP_MEMORY_SCOPE_AGENT); }
__device__ __forceinline__ unsigned xb_xcc_id() { return (unsigned)__builtin_amdgcn_s_getreg((3 << 11) | 20) & 0xFu; }
#define XB_SPIN(cond, bar) do { unsigned _sp = 0; while (cond) { __builtin_amdgcn_s_sleep(1); \
    if ((++_sp & 255u) == 0u) { if (xb_ld(&(bar)[XB_TMO])) break; if (_sp > XB_SPIN_CAP) { atomicAdd(&(bar)[XB_TMO], 1u); break; } } } } while (0)
struct XcdBarrier { unsigned* bar; unsigned x; volatile LAS unsigned* st; };
__device__ __forceinline__ bool xb_leader(int wave_id) { return wave_id == 0 && __builtin_amdgcn_mbcnt_hi(~0u, __builtin_amdgcn_mbcnt_lo(~0u, 0u)) == 0u; }
__device__ __forceinline__ XcdBarrier xcd_barrier_post(unsigned* bar, volatile LAS unsigned* st) {
    XcdBarrier b; b.bar = bar; b.x = xb_xcc_id(); b.st = st;
    if (threadIdx.x == 0) (void)xb_add(&bar[XB_XCNT(b.x)], 1u);
    return b;
}
__device__ __forceinline__ void xcd_barrier_complete(unsigned* bar, unsigned x, unsigned& nloc, unsigned& nx) {
    const unsigned G = gridDim.x * gridDim.y * gridDim.z;
    unsigned sum, cnt, mine, sp = 0u;
    for (;;) {
        sum = 0u; cnt = 0u; mine = 0u;
#pragma unroll
        for (unsigned j = 0; j < 16; ++j) { const unsigned c = xb_ld(&bar[XB_XCNT(j)]); sum += c; cnt += (c > 0u) ? 1u : 0u; mine = (j == x) ? c : mine; }
        if (sum == G) break;
        __builtin_amdgcn_s_sleep(1);
        if ((++sp & 255u) == 0u) { if (xb_ld(&bar[XB_TMO])) break; if (sp > XB_SPIN_CAP) { atomicAdd(&bar[XB_TMO], 1u); break; } }
    }
    nloc = mine > 0u ? mine : 1u; nx = cnt > 0u ? cnt : 1u;
}
__device__ __forceinline__ void xcd_barrier(const XcdBarrier& b, int wave_id) {
    asm volatile("s_waitcnt vmcnt(0)" ::: "memory");
    __syncthreads();
    if (xb_leader(wave_id)) {
        unsigned* bar = b.bar;
        __builtin_amdgcn_s_waitcnt(0);
        unsigned nloc = b.st[0], nx = b.st[1];
        if (nloc == 0u) { xcd_barrier_complete(bar, b.x, nloc, nx); b.st[0] = nloc; b.st[1] = nx; }
        const unsigned old = xb_add(&bar[XB_XSUB(b.x)], 1u);
        const unsigned gen = old / nloc;
        if (old + 1u == (gen + 1u) * nloc) {
            __builtin_amdgcn_fence(__ATOMIC_RELEASE, "agent");
            asm volatile("s_waitcnt vmcnt(0)" ::: "memory");
            const unsigned og = xb_add(&bar[XB_TOP], 1u);
            const unsigned tg = og / nx;
            if (og + 1u == (tg + 1u) * nx) xb_add(&bar[XB_TOPGEN], 1u);
            else XB_SPIN(xb_ld(&bar[XB_TOPGEN]) == tg, bar);
            __builtin_amdgcn_fence(__ATOMIC_ACQUIRE, "agent");
            xb_add(&bar[XB_XGEN(b.x)], 1u);
            asm volatile("s_waitcnt vmcnt(0)" ::: "memory");
        } else {
            XB_SPIN(xb_ld(&bar[XB_XGEN(b.x)]) == gen, bar);
            __builtin_amdgcn_fence(__ATOMIC_ACQUIRE, "agent");
            asm volatile("s_waitcnt vmcnt(0)" ::: "memory");
        }
    }
    __syncthreads();
}

#define LDS_WAIT() asm volatile("s_waitcnt lgkmcnt(0)" ::: "memory")
__device__ __forceinline__ float row16_sum(float v) {
    v += __int_as_float(__builtin_amdgcn_update_dpp(0, __float_as_int(v), 0x128, 0xF, 0xF, false));
    v += __int_as_float(__builtin_amdgcn_update_dpp(0, __float_as_int(v), 0x124, 0xF, 0xF, false));
    v += __int_as_float(__builtin_amdgcn_update_dpp(0, __float_as_int(v), 0x122, 0xF, 0xF, false));
    v += __int_as_float(__builtin_amdgcn_update_dpp(0, __float_as_int(v), 0x121, 0xF, 0xF, false));
    return v;
}
__device__ __forceinline__ float wave_sum(float v) {
#pragma unroll
    for (int o = 1; o < 64; o <<= 1) v += __shfl_xor(v, o);
    return v;
}
template <int R, int WI> __device__ __forceinline__ void conv_steps(f32x2 (&y)[R], const f32x2 (&wt)[31], const unsigned* up) {
    const unsigned uv = up[(size_t)WI * (DCONV / 2)];
    const f32x2 a = (f32x2){bf2f(uv & 0xffffu), __uint_as_float(uv & 0xffff0000u)};
    constexpr int lo = WI - 30 > 0 ? WI - 30 : 0, hi = WI < R - 1 ? WI : R - 1;
#pragma unroll
    for (int r = lo; r <= hi; ++r) y[r] += wt[WI - r] * a;
    if constexpr (R > 16 && (WI % 16) == 15) asm volatile("" ::: "memory");
    if constexpr (WI + 1 < R + 30) conv_steps<R, WI + 1>(y, wt, up);
}
template <int R> __device__ __forceinline__ void conv_unit(
    const unsigned* U32, bf16_t* CAp, LAS float* red, int row0, int tid, int lane, int wave,
                                                           const f32x2 (&wt)[31], f32x2 bv, f32x2 lg, f32x2 lb) {
    constexpr int NS = 2 * R;
    const int ur0 = urow(row0) - 30, c0 = 2 * tid;
    f32x2 y[R];
#pragma unroll
    for (int r = 0; r < R; ++r) y[r] = bv;
    conv_steps<R, 0>(y, wt, U32 + (size_t)ur0 * (DCONV / 2) + tid);
#pragma unroll
    for (int h = 0; h < R; h += 4) {
        float st[8];
#pragma unroll
        for (int r = 0; r < 4; ++r) { st[r] = row16_sum(y[h + r][0] + y[h + r][1]); st[4 + r] = row16_sum(y[h + r][0] * y[h + r][0] + y[h + r][1] * y[h + r][1]); }
        if ((lane & 15) == 0) {
            LAS float* d = red + (wave * 4 + (lane >> 4)) * NS;
            *(LAS f32x4*)(d + h) = (f32x4){st[0], st[1], st[2], st[3]}; *(LAS f32x4*)(d + R + h) = (f32x4){st[4], st[5], st[6], st[7]};
        }
    }
    __syncthreads();
    constexpr int NR = (NS + 63) / 64;
    float tot[NR];
#pragma unroll
    for (int k = 0; k < NR; ++k) { const int idx = 64 * k + lane; float t = 0.f;
        if (idx < NS) {
#pragma unroll
            for (int p = 0; p < 32; ++p) t += red[p * NS + idx]; }
        tot[k] = t; }
    const int idx2 = R + lane; const float s1v = tot[0];
    float s2v = __shfl(tot[0], idx2 & 63);
    if constexpr (NR > 1) { const float v1 = __shfl(tot[NR - 1], idx2 & 63); s2v = idx2 < 64 ? s2v : v1; }
    const float mu_l = s1v * (1.0f / DCONV), var_l = fmaxf(s2v * (1.0f / DCONV) - mu_l * mu_l, 0.f), rstd_l = rsqrtf(var_l + EPS);
#pragma unroll
    for (int r = 0; r < R; ++r) {
        const float mu = __int_as_float(__builtin_amdgcn_readlane(__float_as_int(mu_l), r)), rstd = __int_as_float(__builtin_amdgcn_readlane(__float_as_int(rstd_l), r));
        const float z0 = (y[r][0] - mu) * rstd * lg[0] + lb[0], z1 = (y[r][1] - mu) * rstd * lg[1] + lb[1];
        *(unsigned*)(CAp + (size_t)(row0 + r) * DM + c0) = cvt_pk_bf16(z0 * fsigmoid(z0), z1 * fsigmoid(z1));
    }
}
struct Args { const float* in[27]; float* out; unsigned char* ws; int ph_lo, ph_hi, coop, pad; };

__global__ void __launch_bounds__(NWAVES * 64, 2) mk_fwd(Args args) {
    extern __shared__ __attribute__((aligned(16))) unsigned char lds_raw[];
    LAS unsigned char* lds = (LAS unsigned char*)lds_raw;
    volatile LAS unsigned* MISC = (volatile LAS unsigned*)(lds + MISC_OFF);
    const int wave0 = __builtin_amdgcn_readfirstlane(threadIdx.x >> 6);
    const int G = gridDim.x, bx = blockIdx.x;
#define PHASE_IDS int lane_p = __builtin_amdgcn_mbcnt_hi(~0u, __builtin_amdgcn_mbcnt_lo(~0u, 0u)); asm volatile("" : "+v"(lane_p)); const int lane = lane_p, wave = wave0, tid = wave * 64 + lane; (void)lane; (void)wave; (void)tid
    unsigned char* ws = args.ws; float* out = args.out;
    unsigned* ctl = (unsigned*)(ws + WS_CTL);
    const float* x_p = args.in[0]; const float* x_s = args.in[1]; const float* p_p = args.in[2]; const float* p_s = args.in[3];
    const float* state_conv = args.in[4]; const float* cache_k = args.in[5]; const float* cache_v = args.in[6];
    bf16_t* Wgu1 = (bf16_t*)(ws + WS_WGU1); bf16_t* Wd1 = (bf16_t*)(ws + WS_WD1); bf16_t* Win = (bf16_t*)(ws + WS_WIN);
    bf16_t* Wcat = (bf16_t*)(ws + WS_WCO); bf16_t* Wout = (bf16_t*)(ws + WS_WOUT);
    static_assert(WS_WAO - WS_WCO == (size_t)DM * DCONV * 2 && WS_WOUT - WS_WCO == (size_t)DM * DM * 2, "Wcat");
    bf16_t* Wgu2 = (bf16_t*)(ws + WS_WGU2); bf16_t* Wd2 = (bf16_t*)(ws + WS_WD2); bf16_t* Wpg = (bf16_t*)(ws + WS_WPG); bf16_t* Wpe = (bf16_t*)(ws + WS_WPE);
    bf16_t* XB = (bf16_t*)(ws + WS_XB);
    bf16_t* CAO = (bf16_t*)(ws + WS_WD1);
    static_assert(WS_WCO - WS_WD1 >= (size_t)2 * M * DCONV * 2, "cA | o overlay"); bf16_t* PB = (bf16_t*)(ws + WS_PB);
    float* cosT = (float*)(ws + WS_ROPE); float* sinT = cosT + 4160 * 8;
    float* SS0 = (float*)(ws + WS_SS); float* SS1 = (float*)(ws + WS_SS + SS_BYTES); float* SS2 = (float*)(ws + WS_SS + 2 * SS_BYTES);
    float* SS3 = (float*)(ws + WS_SS + 3 * SS_BYTES); float* SS4 = (float*)(ws + WS_SS + 4 * SS_BYTES);
    unsigned char* R = ws + WS_R;
    bf16_t* HID = (bf16_t*)R; bf16_t* UB = (bf16_t*)(R + R_U); bf16_t* QB = (bf16_t*)(R + R_Q); bf16_t* KB = (bf16_t*)(R + R_K); bf16_t* VB = (bf16_t*)(R + R_V);
    bf16_t* GA = (bf16_t*)(R + R_GA); bf16_t* GB = (bf16_t*)(R + R_GB); bf16_t* MG = (bf16_t*)R;
    static_assert(R_GA >= (size_t)M * DM * 2, "merged overlay");
    bf16_t* PROJ = (bf16_t*)(ws + WS_PROJ);
    float* SLAB = (float*)(ws + WS_SLAB); unsigned* FLAG = ctl + CW_FLAG;

    for (int u = threadIdx.x; u < (LDS_BYTES - LDSCTL_OFF) / 4; u += NWAVES * 64) ((LAS unsigned*)(lds + LDSCTL_OFF))[u] = 0u;
    __syncthreads();
    XcdBarrier bar; bar.bar = ctl + CW_BAR; bar.x = 0; bar.st = nullptr;
    if (args.coop) bar = xcd_barrier_post(ctl + CW_BAR, MISC + 8);
    const int lo = args.ph_lo, hi = args.ph_hi;
#define IN(k) (lo <= (k) && (k) < hi)
#define SEAM(k) do { if (IN(k) && IN((k) + 1)) xcd_barrier(bar, wave0); } while (0)

    constexpr int I_GU = (DM / 64) * (2 * DFF / 64), I_D = (DFF / 64) * (DM / 64), I_IN = (DM / 64) * (INC / 64), I_C = (DCONV / 64) * (DM / 64),
                  I_O = (DM / 64) * (DM / 64), I_PE = (DPLE / 64) * (DM / 64);
#define RUN_ITEMS(PICK, NIT, GW, NGW_) do { float va[64], vb[64]; int it = (GW); \
        if (it < (NIT)) { TItem ta = PICK(it); titem_load(ta, lane, va); \
            for (;;) { const int it2 = it + (NGW_); TItem tb = ta; \
                if (it2 < (NIT)) { tb = PICK(it2); titem_load(tb, lane, vb); } \
                titem_store(ta, lane, va, lds + wave * 9216); \
                if (it2 >= (NIT)) break; \
                const int it3 = it2 + (NGW_); \
                if (it3 < (NIT)) { ta = PICK(it3); titem_load(ta, lane, va); } \
                titem_store(tb, lane, vb, lds + wave * 9216); \
                if (it3 >= (NIT)) break; \
                it = it3; } } } while (0)
    if (IN(0)) {
        PHASE_IDS;
        const int gw = bx * NWAVES + wave, NGW = G * NWAVES;
        const int NITEMS_A = I_GU + I_IN + I_O + I_PE + ((G == 256) ? 0 : I_D + 2 * I_C + I_O);
        auto pick = [&](int it) -> TItem {
            int r = it;
            if (r < I_GU) return TItem{args.in[8], Wgu1, args.in[7], DM, 2 * DFF, 1, r, DM, 0}; r -= I_GU;
            if (r < I_IN) return TItem{args.in[11], Win, args.in[10], DM, INC, 2, r, DM, 0}; r -= I_IN;
            if (r < I_O) return TItem{args.in[24], Wpg, args.in[23], DM, DM, 0, r, DM, 0}; r -= I_O;
            if (r < I_PE) return TItem{args.in[25], Wpe, nullptr, DPLE, DM, 0, r, DPLE, 0}; r -= I_PE;
            if (r < I_D) return TItem{args.in[9], Wd1, nullptr, DFF, DM, 0, r, DFF, 0}; r -= I_D;
            if (r < I_C) return TItem{args.in[16], Wcat, nullptr, DCONV, DM, 0, r, DM, 0}; r -= I_C;
            if (r < I_C) return TItem{args.in[18], Wcat, nullptr, QW, DM, 0, r, DM, DCONV}; r -= I_C;
            return TItem{args.in[19], Wout, nullptr, DM, DM, 0, r, DM, 0};
        };
        RUN_ITEMS(pick, NITEMS_A, gw, NGW);
        for (int row = gw; row < M; row += NGW) {
            const float* xr = row < MP ? x_p + (size_t)row * DM : x_s + (size_t)(row - MP) * DM;
            f32x4 v[8]; float s = 0.f;
#pragma unroll
            for (int j = 0; j < 8; ++j) { v[j] = ((const f32x4*)xr)[lane + 64 * j]; s += (v[j][0] * v[j][0] + v[j][1] * v[j][1]) + (v[j][2] * v[j][2] + v[j][3] * v[j][3]); }
            s = wave_sum(s);
#pragma unroll
            for (int j = 0; j < 8; ++j) { u32x2 w; w.x = cvt_pk_bf16(v[j][0], v[j][1]); w.y = cvt_pk_bf16(v[j][2], v[j][3]); ((u32x2*)(XB + (size_t)row * DM))[lane + 64 * j] = w; }
            if (lane < 32) SS0[(size_t)row * 32 + lane] = (lane == 0) ? s : 0.f;
            const float* pr = row < MP ? p_p + (size_t)row * DPLE : p_s + (size_t)(row - MP) * DPLE;
            const f32x4 pv = ((const f32x4*)pr)[lane]; u32x2 w; w.x = cvt_pk_bf16(pv[0], pv[1]); w.y = cvt_pk_bf16(pv[2], pv[3]);
            ((u32x2*)(PB + (size_t)row * DPLE))[lane] = w;
        }
        for (int e = bx * 512 + tid; e < NBS * 64 * KVW / 4; e += G * 512) {
            const int b = e / (64 * KVW / 4), r = e % (64 * KVW / 4);
            ((f32x4*)(out + OFF_KS + (size_t)b * WIN * KVW))[r] = ((const f32x4*)(cache_k + (size_t)(b * WIN + 64) * KVW))[r];
            ((f32x4*)(out + OFF_VS + (size_t)b * WIN * KVW))[r] = ((const f32x4*)(cache_v + (size_t)(b * WIN + 64) * KVW))[r];
        }
        if (args.coop == 2) { cg::this_grid().sync(); }
        SEAM(0);
    }

    if (IN(1)) {
        pg8::Gemm g{XB, Wgu1, M, 2 * DFF, DM}; pg8::StaticOrder S; S.init(M, 2 * DFF, DM, G, bx);
        EpiSwiGLU E{SideWork{args.in[9], args.in[16], args.in[18], args.in[19], ws, (G == 256) ? SIDE_ITEMS : 0, G, bx}, SS0, HID, (const LAS float*)(lds + RST_OFF)};
        pg8::gemm_phase<EpiSwiGLU, pg8::StaticOrder, true, true>(lds, wave0, g, S, E);
        {
            const int ntiles = (M / 256) * (2 * DFF / 256), full = ntiles / G, first = ntiles - full * G;
            if (bx >= first) {
                PHASE_IDS;
                auto pick2 = [&](int it) -> TItem {
                    if (it < I_GU) return TItem{args.in[21], Wgu2, args.in[20], DM, 2 * DFF, 1, it, DM, 0};
                    return TItem{args.in[22], Wd2, nullptr, DFF, DM, 0, it - I_GU, DFF, 0};
                };
                RUN_ITEMS(pick2, I_GU + I_D, (bx - first) * NWAVES + wave, (G - first) * NWAVES);
            }
        }
        SEAM(1);
    }
    if (IN(2)) {
        pg8::Gemm g{HID, Wd1, M, DM, DFF}; pg8::StreamK S; S.init(DFF, G, bx);
        EpiResid E{XB, SS1, 0.5f};
        pg8::gemm_phase<EpiResid, pg8::StreamK, true, true>(lds, wave0, g, S, E, SLAB, FLAG);
        SEAM(2);
    }
    if (IN(3)) {
        { PHASE_IDS;
        for (int e = bx * 512 + tid; e < (NBP + NBS) * 30 * (DCONV / 2); e += G * 512) {
            const int sq = e / (30 * (DCONV / 2)), rem = e % (30 * (DCONV / 2)), r = rem / (DCONV / 2), c2 = rem % (DCONV / 2);
            unsigned val = 0u; int ur;
            if (sq < NBP) ur = sq * (SEQ + 30) + r;
            else { const int sb = sq - NBP; ur = NBP * (SEQ + 30) + sb * (DSEQ + 30) + r; const f32x2 sv = *(const f32x2*)(state_conv + (size_t)(sb * 30 + r) * DCONV + 2 * c2); val = cvt_pk_bf16(sv[0], sv[1]); }
            ((unsigned*)UB)[(size_t)ur * (DCONV / 2) + c2] = val;
        }
        }
        pg8::Gemm g{XB, Win, M, INC, DM}; pg8::InOrder S; S.init(M, INC, DM, G, bx);
        EpiIn E{SS1, (const LAS float*)(lds + RST_OFF), UB, QB, KB, VB, GA, GB, cosT, sinT, out};
        pg8::gemm_phase<EpiIn, pg8::InOrder, true, true>(lds, wave0, g, S, E);
        SEAM(3);
    }
    if (IN(4)) {
        PHASE_IDS;
        constexpr int N_ATT = 136 * 4, N_CONV = M / 16;
        for (int item = bx; item < N_ATT; item += G) {
            {
                const bf16_t* KBp = KB; const bf16_t* VBp = VB; const bf16_t* QBp = QB; bf16_t* OBp = CAO + DCONV; const float* ckp = cache_k; const float* cvp = cache_v;
                const int cidx = item >> 2, kvh = item & 3;
                const bool samp = cidx >= 128;
                const int b = samp ? cidx - 128 : cidx >> 6, c = samp ? 2 : (cidx & 63);
                const int qrow0 = samp ? MP + b * 64 : b * SEQ + c * 64;
                LAS bf16_t* Ks = (LAS bf16_t*)lds;
                LAS bf16_t* Vt = (LAS bf16_t*)(lds + 192 * 72 * 2);
#pragma unroll
                for (int it = 0; it < 3; ++it) {
                    const int idx = it * 512 + tid, key = idx >> 3, ch = idx & 7;
                    u32x4 w = (u32x4){0u, 0u, 0u, 0u};
                    if (samp && key < 128) {
                        const float* src = ckp + ((size_t)(b * WIN + key) * 4 + kvh) * 64 + ch * 8;
                        const f32x4 a = *(const f32x4*)src, bb = *(const f32x4*)(src + 4);
                        w.x = cvt_pk_bf16(a[0], a[1]); w.y = cvt_pk_bf16(a[2], a[3]); w.z = cvt_pk_bf16(bb[0], bb[1]); w.w = cvt_pk_bf16(bb[2], bb[3]);
                    } else {
                        const int kc = c - 2 + (key >> 6);
                        if (kc >= 0) { const int grow = samp ? MP + b * 64 + (key - 128) : b * SEQ + kc * 64 + (key & 63);
                            w = *(const u32x4*)(KBp + (size_t)grow * KVW + kvh * 64 + ch * 8); }
                    }
                    *(LAS u32x4*)(Ks + key * 72 + ch * 8) = w;
                }
#pragma unroll
                for (int it = 0; it < 3; ++it) {
                    const int blk = it * 8 + wave, key = (blk % 3) * 64 + lane, j = blk / 3;
                    u32x4 w = (u32x4){0u, 0u, 0u, 0u};
                    if (samp && key < 128) {
                        const float* src = cvp + ((size_t)(b * WIN + key) * 4 + kvh) * 64 + j * 8;
                        const f32x4 a = *(const f32x4*)src, bb = *(const f32x4*)(src + 4);
                        w.x = cvt_pk_bf16(a[0], a[1]); w.y = cvt_pk_bf16(a[2], a[3]); w.z = cvt_pk_bf16(bb[0], bb[1]); w.w = cvt_pk_bf16(bb[2], bb[3]);
                    } else {
                        const int kc = c - 2 + (key >> 6);
                        if (kc >= 0) { const int grow = samp ? MP + b * 64 + (key - 128) : b * SEQ + kc * 64 + (key & 63);
                            w = *(const u32x4*)(VBp + (size_t)grow * KVW + kvh * 64 + j * 8); }
                    }
                    const int kp = (key & ~15) | swap23(key & 15);
#pragma unroll
                    for (int i = 0; i < 4; ++i) { Vt[(8 * j + 2 * i) * 200 + kp] = (bf16_t)(w[i] & 0xffffu); Vt[(8 * j + 2 * i + 1) * 200 + kp] = (bf16_t)(w[i] >> 16); }
                }
                const int r32 = lane & 31, hi = lane >> 5;
                const int head = kvh * 4 + (wave >> 1), qrow = qrow0 + 32 * (wave & 1) + r32;
                bf16x8 qr[4];
#pragma unroll
                for (int ks = 0; ks < 4; ++ks) qr[ks] = *(const bf16x8*)(QBp + (size_t)qrow * QW + head * 64 + ks * 16 + hi * 8);
                const float sink = args.in[17][head];
                __syncthreads();
                f32x16 p[6];
                const int kb0 = samp ? 0 : (c >= 2 ? 0 : (c == 1 ? 2 : 4));
#pragma unroll
                for (int kb = 0; kb < 6; ++kb) {
                    f32x16 a = {};
#pragma unroll
                    for (int ks = 0; ks < 4; ++ks) {
                        const bf16x8 kf = *(const LAS bf16x8*)(Ks + (kb * 32 + r32) * 72 + ks * 16 + hi * 8);
                        a = __builtin_amdgcn_mfma_f32_32x32x16_bf16(kf, qr[ks], a, 0, 0, 0);
                    }
                    p[kb] = a;
                }
                float mxa[4] = {sink, sink, sink, sink};
#pragma unroll
                for (int kb = 0; kb < 6; ++kb) { if (kb >= kb0) {
#pragma unroll
                    for (int r = 0; r < 16; ++r) mxa[r & 3] = fmaxf(mxa[r & 3], p[kb][r]); } }
                float mx = fmaxf(fmaxf(mxa[0], mxa[1]), fmaxf(mxa[2], mxa[3]));
                mx = fmaxf(mx, __shfl_xor(mx, 32));
                const float L2E = 1.4426950408889634f, nm = -mx * L2E;
                float la[4] = {0.f, 0.f, 0.f, 0.f};
#pragma unroll
                for (int kb = 0; kb < 6; ++kb) {
#pragma unroll
                    for (int r = 0; r < 16; ++r) { const float e = (kb >= kb0) ? __builtin_amdgcn_exp2f(__builtin_fmaf(p[kb][r], L2E, nm)) : 0.f; p[kb][r] = e; la[r & 3] += e; } }
                float l = (la[0] + la[1]) + (la[2] + la[3]);
                l += __shfl_xor(l, 32);
                l += __builtin_amdgcn_exp2f(__builtin_fmaf(sink, L2E, nm));
                const float rl = 1.0f / l;
                f32x16 o[2] = {{}, {}};
#pragma unroll
                for (int kb = 0; kb < 6; ++kb)
#pragma unroll
                    for (int j = 0; j < 2; ++j) {
                        u32x4 pw; pw.x = cvt_pk_bf16(p[kb][8 * j + 0], p[kb][8 * j + 1]); pw.y = cvt_pk_bf16(p[kb][8 * j + 2], p[kb][8 * j + 3]);
                        pw.z = cvt_pk_bf16(p[kb][8 * j + 4], p[kb][8 * j + 5]); pw.w = cvt_pk_bf16(p[kb][8 * j + 6], p[kb][8 * j + 7]);
                        const bf16x8 pf = __builtin_bit_cast(bf16x8, pw);
#pragma unroll
                        for (int db = 0; db < 2; ++db) {
                            const bf16x8 vf = *(const LAS bf16x8*)(Vt + (db * 32 + r32) * 200 + kb * 32 + j * 16 + hi * 8);
                            o[db] = __builtin_amdgcn_mfma_f32_32x32x16_bf16(vf, pf, o[db], 0, 0, 0);
                        }
                    }
#pragma unroll
                for (int db = 0; db < 2; ++db)
#pragma unroll
                    for (int i = 0; i < 4; i += 2) {
                        unsigned ax = cvt_pk_bf16(o[db][4 * i] * rl, o[db][4 * i + 1] * rl), ay = cvt_pk_bf16(o[db][4 * i + 2] * rl, o[db][4 * i + 3] * rl);
                        unsigned bx_ = cvt_pk_bf16(o[db][4 * i + 4] * rl, o[db][4 * i + 5] * rl), by_ = cvt_pk_bf16(o[db][4 * i + 6] * rl, o[db][4 * i + 7] * rl);
                        { auto r = __builtin_amdgcn_permlane32_swap(ax, bx_, false, false); ax = r[0]; bx_ = r[1]; }
                        { auto r = __builtin_amdgcn_permlane32_swap(ay, by_, false, false); ay = r[0]; by_ = r[1]; }
                        *(u32x4*)(OBp + (size_t)qrow * DM + head * 64 + db * 32 + 8 * i + 8 * hi) = (u32x4){ax, ay, bx_, by_};
                    }
                __syncthreads();
            }
        }
        {
            const int c0 = 2 * tid;
            f32x2 wt[31];
#pragma unroll
            for (int j = 0; j < 31; ++j) wt[j] = *(const f32x2*)(args.in[12] + (size_t)j * DCONV + c0);
            const f32x2 bv = *(const f32x2*)(args.in[13] + c0), lg = *(const f32x2*)(args.in[14] + c0), lb = *(const f32x2*)(args.in[15] + c0);
            const unsigned* U32 = (const unsigned*)UB;
            LAS float* red = (LAS float*)lds;
            if (G == 256) {
                if (bx < 32) conv_unit<16>(U32, CAO, red, MP + bx * 16, tid, lane, wave, wt, bv, lg, lb);
                else { const int l = bx - 32, sq = l / 112, k = l % 112;
                    if (k < 96) conv_unit<36>(U32, CAO, red, sq * SEQ + 36 * k, tid, lane, wave, wt, bv, lg, lb);
                    else conv_unit<40>(U32, CAO, red, sq * SEQ + 3456 + 40 * (k - 96), tid, lane, wave, wt, bv, lg, lb); }
            } else {
                int it = 0;
                for (int cu = bx; cu < N_CONV; cu += G, ++it) conv_unit<16>(U32, CAO, red + (it & 1) * 2048, cu * 16, tid, lane, wave, wt, bv, lg, lb);
            }
            __syncthreads();
        }
        SEAM(4);
    }
    if (IN(5)) {
        pg8::StreamK S; S.init(DM, G, bx);
        pg8::Gemm g{CAO, Wcat, M, DM, DM}; EpiMerge E{GA, GB, MG};
        pg8::gemm_phase<EpiMerge, pg8::StreamK, true, true, 16>(lds, wave0, g, S, E, SLAB, FLAG + 512);
        SEAM(5);
    }
    if (IN(6)) {
        pg8::Gemm g{MG, Wout, M, DM, DM}; pg8::StreamK S; S.init(DM, G, bx);
        EpiResid E{XB, SS2, 1.0f};
        pg8::gemm_phase<EpiResid, pg8::StreamK, true, true>(lds, wave0, g, S, E, SLAB, FLAG + 1536);
        SEAM(6);
    }
    if (IN(7)) {
        pg8::Gemm g{XB, Wgu2, M, 2 * DFF, DM}; pg8::StaticOrder S; S.init(M, 2 * DFF, DM, G, bx);
        EpiSwiGLU E{SideWork{nullptr, nullptr, nullptr, nullptr, ws, 0, G, bx}, SS2, HID, (const LAS float*)(lds + RST_OFF)};
        pg8::gemm_phase<EpiSwiGLU, pg8::StaticOrder, true, true>(lds, wave0, g, S, E);
        {
            const int ntiles = (M / 256) * (2 * DFF / 256), full = ntiles / G, first = ntiles - full * G;
            pg8::Gemm g2{PB, Wpe, M, DM, DPLE}; pg8::SlackOrder S2; S2.init(DPLE, G, first, bx);
            EpiBf16 E2{PROJ};
            pg8::gemm_phase<EpiBf16, pg8::SlackOrder, true, true>(lds, wave0, g2, S2, E2);
        }
        SEAM(7);
    }
    if (IN(8)) {
        pg8::Gemm g{HID, Wd2, M, DM, DFF}; pg8::StreamK S; S.init(DFF, G, bx);
        EpiResid E{XB, SS3, 0.5f};
        pg8::gemm_phase<EpiResid, pg8::StreamK, true, true>(lds, wave0, g, S, E, SLAB, FLAG + 2048);
        SEAM(8);
    }
    if (IN(9)) {
        pg8::Gemm g{XB, Wpg, M, DM, DM}; pg8::StreamK S; S.init(DM, G, bx);
        EpiPle E{SS3, (bf16_t*)R, XB, PROJ, (const LAS float*)(lds + RST_OFF), SS4};
        pg8::gemm_phase<EpiPle, pg8::StreamK, true, true>(lds, wave0, g, S, E, SLAB, FLAG + 2560);
        SEAM(9);
    }
    if (IN(10)) {
        PHASE_IDS;
        const float* fn = args.in[26];
        pg8::StreamK S; S.init(DM, G, bx); pg8::Unit u;
        for (int i = 0; S.next(i, u); ++i) {
            if (u.kind == 1) continue;
            const f32x4 gn = *(const f32x4*)(fn + u.pn * 256 + 4 * lane);
            const f32x4* pp = (const f32x4*)(SS4 + (size_t)(u.pm * 256 + wave * 32 + (lane & 31)) * 32);
            f32x4 a4 = pp[0];
#pragma unroll
            for (int j = 1; j < 8; ++j) a4 += pp[j];
            const float rs_l = rsqrtf(((a4[0] + a4[1]) + (a4[2] + a4[3])) * (1.0f / DM) + EPS);
            const u32x2* q0 = (const u32x2*)((const bf16_t*)R + (size_t)(u.pm * 256 + wave * 32) * DM + u.pn * 256) + lane;
            f32x4* p0 = (f32x4*)(out + (size_t)(u.pm * 256 + wave * 32) * DM + u.pn * 256) + lane;
#pragma unroll
            for (int r0 = 0; r0 < 32; r0 += 8) {
                u32x2 v[8];
#pragma unroll
                for (int k = 0; k < 8; ++k) v[k] = q0[(size_t)(r0 + k) * (DM / 4)];
#pragma unroll
                for (int k = 0; k < 8; ++k) { const float rs = __shfl(rs_l, r0 + k);
                    const f32x4 xv = (f32x4){bf2f(v[k].x & 0xffffu), __uint_as_float(v[k].x & 0xffff0000u), bf2f(v[k].y & 0xffffu), __uint_as_float(v[k].y & 0xffff0000u)};
                    __builtin_nontemporal_store(xv * rs * gn, p0 + (size_t)(r0 + k) * (DM / 4)); }
            }
        }
    }
#undef IN
#undef SEAM
}

extern "C" void kernel_launch(void* const* d_in, const int* in_sizes, int n_in, void* d_out, int out_size, void* d_ws, size_t ws_size, hipStream_t stream) {
    static int grid = 0;
    if (grid == 0) {
        if (n_in != 27 || (size_t)out_size != OUT_TOTAL || ws_size < WS_END) {
            fprintf(stderr, "kernel_launch: unexpected shapes: n_in %d out %d ws %zu (need %zu)\n", n_in, out_size, ws_size, (size_t)WS_END); grid = -1; return; }
        int dev = 0, cus = 0, per_cu = 0;
        if (hipGetDevice(&dev) != hipSuccess || hipDeviceGetAttribute(&cus, hipDeviceAttributeMultiprocessorCount, dev) != hipSuccess) { grid = -1; return; }
        if (hipFuncSetAttribute((const void*)mk_fwd, hipFuncAttributeMaxDynamicSharedMemorySize, LDS_BYTES) != hipSuccess) { fprintf(stderr, "kernel_launch: hipFuncSetAttribute failed\n"); grid = -1; return; }
        if (hipOccupancyMaxActiveBlocksPerMultiprocessor(&per_cu, (const void*)mk_fwd, NWAVES * 64, LDS_BYTES) != hipSuccess || per_cu < 1) { fprintf(stderr, "kernel_launch: occupancy query failed (%d)\n", per_cu); (void)hipGetLastError(); grid = -1; return; }
        grid = cus * 1;
    }
    if (grid < 0) return;
    (void)hipMemsetAsync((char*)d_ws + WS_CTL, 0, CTL_ZERO_BYTES, stream);
    Args a{};
    for (int i = 0; i < 27; ++i) a.in[i] = (const float*)d_in[i];
    a.out = (float*)d_out; a.ws = (unsigned char*)d_ws;
#if MK_N_LAUNCHES == 1
    a.ph_lo = 0; a.ph_hi = 11; a.coop = 1;
    void* kargs[] = {&a};
    hipError_t e = hipLaunchCooperativeKernel((const void*)mk_fwd, dim3(grid), dim3(NWAVES * 64), kargs, LDS_BYTES, stream);
    if (e != hipSuccess) fprintf(stderr, "cooperative launch failed: %s (grid %d)\n", hipGetErrorString(e), grid);
#else
    for (int ph = 0; ph < 11; ++ph) {
        a.ph_lo = ph; a.ph_hi = ph + 1; a.coop = 0;
        hipLaunchKernelGGL(mk_fwd, dim3(grid), dim3(NWAVES * 64), LDS_BYTES, stream, a);
    }
#endif
}
```
